# Optimizing an MI355X kernel written in HIP

```python
import jax
import jax.numpy as jnp
from jax import lax
import numpy as np

D_MODEL = 1024
BATCH = 32
SEQ = 2048
DEPTH = 2

CHUNK = 64
D_PLE = 256
N_EVEN = (DEPTH + 1) // 2
N_ODD = DEPTH // 2
D_FF = 2816
A_HEADS = 8
A_KV_HEADS = 2
A_GROUP = A_HEADS // A_KV_HEADS
A_HEAD_DIM = 64
A_WIDTH = A_HEADS * A_HEAD_DIM
A_KV_WIDTH = A_KV_HEADS * A_HEAD_DIM
A_WINDOW = 128
A_PREV_CHUNKS = A_WINDOW // CHUNK
B_WIDTH = 512
B_BLOCKS = 8
B_BLOCK = B_WIDTH // B_BLOCKS
B_CONV = 4
RG_C = 8.0
AB_PROJ = A_WIDTH + 2 * A_KV_WIDTH + 2 * B_WIDTH
C_HEADS = 8
C_HEAD_DIM = 128
C_WIDTH = C_HEADS * C_HEAD_DIM
C_CONV = 4
C_PROJ = 4 * C_WIDTH + 2 * C_HEADS
DN_ALPHA = (2.0 * DEPTH) ** 0.25
DN_BETA = (8.0 * DEPTH) ** -0.25
LN_EPS = 1e-5
NORM_EPS = 1e-6
NEG = -1e30

kernel_name = 'hybrid_swa_rglru_gdn_deepnorm_macaron'


def layer_norm(x, g, b):
    xf = x.astype(jnp.float32)
    mu = jnp.mean(xf, -1, keepdims=True)
    var = jnp.mean(jnp.square(xf - mu), -1, keepdims=True)
    return ((xf - mu) * lax.rsqrt(var + LN_EPS) * g + b).astype(x.dtype)


def swiglu(x, wg, wu, wd):
    return (jax.nn.silu(x @ wg) * (x @ wu)) @ wd


def causal_dwconv(x, w):
    k, s = w.shape[0], x.shape[1]
    xp = jnp.pad(x, ((0, 0), (k - 1, 0), (0, 0)))
    y = xp[:, 0:s] * w[0]
    for j in range(1, k):
        y = y + xp[:, j:j + s] * w[j]
    return y


def chunk_band(t, n_prev):
    b, s = t.shape[:2]
    nc = s // CHUNK
    pad = n_prev * CHUNK
    tp = jnp.pad(t, ((0, 0), (pad, 0), (0, 0), (0, 0)))
    return jnp.concatenate(
        [tp[:, j * CHUNK:j * CHUNK + s].reshape(b, nc, CHUNK, *t.shape[2:]) for j in range(n_prev + 1)],
        axis=2)


def alibi_slopes(n):
    return 2.0 ** (-8.0 * jnp.arange(1, n + 1, dtype=jnp.float32) / n)


def sliding_window_sink_attention(q, k, v, sinks):
    b, s = q.shape[:2]
    nc = s // CHUNK
    pad = A_PREV_CHUNKS * CHUNK
    nk = pad + CHUNK
    qb = q.reshape(b, nc, CHUNK, A_KV_HEADS, A_GROUP, A_HEAD_DIM)
    kb = chunk_band(k, A_PREV_CHUNKS)
    vb = chunk_band(v, A_PREV_CHUNKS)
    sc = jnp.einsum('bnckgd,bnskd->bnkgcs', qb, kb).astype(jnp.float32) * (A_HEAD_DIM ** -0.5)
    dist = jnp.abs(jnp.arange(CHUNK)[:, None] + pad - jnp.arange(nk)[None, :]).astype(jnp.float32)
    slopes = alibi_slopes(A_HEADS).reshape(A_KV_HEADS, A_GROUP)
    valid = (jnp.arange(nc)[:, None] * CHUNK + jnp.arange(nk)[None, :] - pad) >= 0
    sc = sc - slopes[:, :, None, None] * dist
    sc = jnp.where(valid[None, :, None, None, None, :], sc, NEG)
    sink = sinks.astype(jnp.float32).reshape(A_KV_HEADS, A_GROUP)[:, :, None]
    m = jnp.maximum(sc.max(-1), sink)
    pr = jnp.exp(sc - m[..., None])
    den = pr.sum(-1) + jnp.exp(sink - m)
    o = jnp.einsum('bnkgcs,bnskd->bnckgd', pr / den[..., None], vb.astype(jnp.float32))
    return o.reshape(b, s, A_WIDTH).astype(q.dtype)


def rg_lru(x, w_a, b_a, w_x, b_x, lam):
    xb = x.reshape(*x.shape[:2], B_BLOCKS, B_BLOCK)
    r = jax.nn.sigmoid(jnp.einsum('bshi,hij->bshj', xb, w_a).reshape(x.shape) + b_a)
    i = jax.nn.sigmoid(jnp.einsum('bshi,hij->bshj', xb, w_x).reshape(x.shape) + b_x)
    log_a = (-RG_C * r * jax.nn.softplus(-lam)).astype(jnp.float32)
    a = jnp.exp(log_a)
    u = jnp.sqrt(-jnp.expm1(2.0 * log_a)) * (i * x).astype(jnp.float32)

    def combine(c1, c2):
        a1, b1 = c1
        a2, b2 = c2
        return a1 * a2, a2 * b1 + b2

    _, h = lax.associative_scan(combine, (a, u), axis=1)
    return h.astype(x.dtype)


def mixer_ab(x, w_in, sinks, conv_w, conv_b, w_a, b_a, w_x, b_x, lam, w_out):
    b, s = x.shape[:2]
    proj = x @ w_in
    o1 = A_WIDTH
    o2 = o1 + A_KV_WIDTH
    o3 = o2 + A_KV_WIDTH
    o4 = o3 + B_WIDTH
    q = proj[..., :o1].reshape(b, s, A_HEADS, A_HEAD_DIM)
    k = proj[..., o1:o2].reshape(b, s, A_KV_HEADS, A_HEAD_DIM)
    v = proj[..., o2:o3].reshape(b, s, A_KV_HEADS, A_HEAD_DIM)
    bx = proj[..., o3:o4]
    bg = proj[..., o4:]
    ya = sliding_window_sink_attention(q, k, v, sinks)
    bx = causal_dwconv(bx, conv_w) + conv_b
    yb = rg_lru(bx, w_a, b_a, w_x, b_x, lam) * jax.nn.gelu(bg)
    return jnp.concatenate([ya, yb], axis=-1) @ w_out


def gated_delta_rule(q, k, v, g, beta):
    f32 = jnp.float32
    b, s, h, dk = q.shape
    dv = v.shape[-1]
    nc = s // CHUNK

    def to_chunks(t):
        return t.astype(f32).reshape(b, nc, CHUNK, h, -1).transpose(1, 0, 3, 2, 4)

    q = to_chunks(q) * (dk ** -0.5)
    k = to_chunks(k)
    v = to_chunks(v)
    g = g.astype(f32).reshape(b, nc, CHUNK, h).transpose(1, 0, 3, 2)
    beta = beta.astype(f32).reshape(b, nc, CHUNK, h).transpose(1, 0, 3, 2)
    gc = jnp.cumsum(g, axis=-1)
    tril = jnp.tril(jnp.ones((CHUNK, CHUNK), bool))
    strict = jnp.tril(jnp.ones((CHUNK, CHUNK), bool), -1)
    diff = gc[..., :, None] - gc[..., None, :]
    decay = jnp.where(tril, jnp.exp(jnp.where(tril, diff, 0.0)), 0.0)
    kb = k * beta[..., None]
    lmat = jnp.where(strict, jnp.einsum('nbhid,nbhjd->nbhij', kb, k) * decay, 0.0)
    amat = lmat + jnp.eye(CHUNK, dtype=f32)
    u = lax.linalg.triangular_solve(amat, v * beta[..., None], left_side=True, lower=True, unit_diagonal=True)
    w = lax.linalg.triangular_solve(amat, kb * jnp.exp(gc)[..., None], left_side=True, lower=True, unit_diagonal=True)
    attn = jnp.einsum('nbhid,nbhjd->nbhij', q, k) * decay
    qg = q * jnp.exp(gc)[..., None]
    kdec = k * jnp.exp(gc[..., -1:] - gc)[..., None]
    glast = jnp.exp(gc[..., -1])

    def step(state, xs):
        qg_n, kdec_n, w_n, u_n, attn_n, gl_n = xs
        v_new = u_n - jnp.einsum('bhcd,bhde->bhce', w_n, state)
        o = jnp.einsum('bhcd,bhde->bhce', qg_n, state) + jnp.einsum('bhij,bhje->bhie', attn_n, v_new)
        state = state * gl_n[..., None, None] + jnp.einsum('bhcd,bhce->bhde', kdec_n, v_new)
        return state, o

    s0 = jnp.zeros((b, h, dk, dv), f32)
    _, o = lax.scan(step, s0, (qg, kdec, w, u, attn, glast))
    return o.transpose(1, 0, 3, 2, 4).reshape(b, s, h, dv)


def mixer_c(x, w_in, conv_w, a_log, dt_bias, norm_g, w_out):
    b, s = x.shape[:2]
    proj = x @ w_in
    qkv = jax.nn.silu(causal_dwconv(proj[..., :3 * C_WIDTH], conv_w))
    z = proj[..., 3 * C_WIDTH:4 * C_WIDTH].reshape(b, s, C_HEADS, C_HEAD_DIM)
    b_logit = proj[..., 4 * C_WIDTH:4 * C_WIDTH + C_HEADS]
    a_in = proj[..., 4 * C_WIDTH + C_HEADS:]
    q = qkv[..., :C_WIDTH].reshape(b, s, C_HEADS, C_HEAD_DIM).astype(jnp.float32)
    k = qkv[..., C_WIDTH:2 * C_WIDTH].reshape(b, s, C_HEADS, C_HEAD_DIM).astype(jnp.float32)
    v = qkv[..., 2 * C_WIDTH:].reshape(b, s, C_HEADS, C_HEAD_DIM)
    q = q * lax.rsqrt(jnp.sum(q * q, -1, keepdims=True) + NORM_EPS)
    k = k * lax.rsqrt(jnp.sum(k * k, -1, keepdims=True) + NORM_EPS)
    beta = jax.nn.sigmoid(b_logit.astype(jnp.float32))
    g = -jnp.exp(a_log.astype(jnp.float32)) * jax.nn.softplus((a_in + dt_bias).astype(jnp.float32))
    o = gated_delta_rule(q, k, v, g, beta)
    o = o * lax.rsqrt(jnp.mean(o * o, -1, keepdims=True) + NORM_EPS) * norm_g
    o = (o * jax.nn.silu(z.astype(jnp.float32))).astype(x.dtype)
    return o.reshape(b, s, C_WIDTH) @ w_out


def setup_inputs(seed: int = 0) -> dict:
    key = jax.random.key(seed)
    ks = iter(jax.random.split(key, 48))
    f32 = jnp.float32

    def nrm(shape, scale):
        return jax.random.normal(next(ks), shape, f32) * scale

    d = D_MODEL
    x = nrm((BATCH, SEQ, d), 1.0)
    p = nrm((DEPTH, BATCH, SEQ, D_PLE), 1.0)
    ffn1_wg = nrm((DEPTH, d, D_FF), d ** -0.5)
    ffn1_wu = nrm((DEPTH, d, D_FF), d ** -0.5)
    ffn1_wd = nrm((DEPTH, D_FF, d), DN_BETA * D_FF ** -0.5)
    ffn2_wg = nrm((DEPTH, d, D_FF), d ** -0.5)
    ffn2_wu = nrm((DEPTH, d, D_FF), d ** -0.5)
    ffn2_wd = nrm((DEPTH, D_FF, d), DN_BETA * D_FF ** -0.5)
    ln_g = 1.0 + nrm((DEPTH, 3, d), 0.02)
    ln_b = nrm((DEPTH, 3, d), 0.02)
    ple_wg = nrm((DEPTH, d, d), d ** -0.5)
    ple_bg = nrm((DEPTH, d), 0.02)
    ple_wp = nrm((DEPTH, D_PLE, d), D_PLE ** -0.5)
    ab_w_in = nrm((N_EVEN, d, AB_PROJ), d ** -0.5)
    a_sinks = nrm((N_EVEN, A_HEADS), 0.5)
    b_conv_w = nrm((N_EVEN, B_CONV, B_WIDTH), B_CONV ** -0.5)
    b_conv_b = nrm((N_EVEN, B_WIDTH), 0.02)
    b_wa = nrm((N_EVEN, B_BLOCKS, B_BLOCK, B_BLOCK), B_BLOCK ** -0.5)
    b_ba = nrm((N_EVEN, B_WIDTH), 0.02)
    b_wx = nrm((N_EVEN, B_BLOCKS, B_BLOCK, B_BLOCK), B_BLOCK ** -0.5)
    b_bx = nrm((N_EVEN, B_WIDTH), 0.02)
    a_c = jax.random.uniform(next(ks), (N_EVEN, B_WIDTH), f32, 0.9, 0.999)
    a0 = a_c ** (1.0 / RG_C)
    b_lam = jnp.log(a0) - jnp.log1p(-a0)
    ab_w_out = nrm((N_EVEN, A_WIDTH + B_WIDTH, d), DN_BETA * (A_WIDTH + B_WIDTH) ** -0.5)
    c_w_in = nrm((N_ODD, d, C_PROJ), d ** -0.5)
    c_conv_w = nrm((N_ODD, C_CONV, 3 * C_WIDTH), C_CONV ** -0.5)
    c_a_log = jnp.log(jax.random.uniform(next(ks), (N_ODD, C_HEADS), f32, 1.0, 16.0))
    dt = jnp.exp(jax.random.uniform(next(ks), (N_ODD, C_HEADS), f32, np.log(1e-3), np.log(1e-1)))
    c_dt_bias = dt + jnp.log(-jnp.expm1(-dt))
    c_norm_g = 1.0 + nrm((N_ODD, C_HEAD_DIM), 0.02)
    c_w_out = nrm((N_ODD, C_WIDTH, d), DN_BETA * C_WIDTH ** -0.5)
    return {'x': x, 'p': p,
            'ffn1_wg': ffn1_wg, 'ffn1_wu': ffn1_wu, 'ffn1_wd': ffn1_wd,
            'ffn2_wg': ffn2_wg, 'ffn2_wu': ffn2_wu, 'ffn2_wd': ffn2_wd,
            'ln_g': ln_g, 'ln_b': ln_b,
            'ple_wg': ple_wg, 'ple_bg': ple_bg, 'ple_wp': ple_wp,
            'ab_w_in': ab_w_in, 'a_sinks': a_sinks,
            'b_conv_w': b_conv_w, 'b_conv_b': b_conv_b,
            'b_wa': b_wa, 'b_ba': b_ba, 'b_wx': b_wx, 'b_bx': b_bx, 'b_lam': b_lam,
            'ab_w_out': ab_w_out,
            'c_w_in': c_w_in, 'c_conv_w': c_conv_w, 'c_a_log': c_a_log, 'c_dt_bias': c_dt_bias,
            'c_norm_g': c_norm_g, 'c_w_out': c_w_out}


def reference(x, p, ffn1_wg, ffn1_wu, ffn1_wd, ffn2_wg, ffn2_wu, ffn2_wd, ln_g, ln_b,
              ple_wg, ple_bg, ple_wp, ab_w_in, a_sinks, b_conv_w, b_conv_b,
              b_wa, b_ba, b_wx, b_bx, b_lam, ab_w_out,
              c_w_in, c_conv_w, c_a_log, c_dt_bias, c_norm_g, c_w_out):
    for i in range(DEPTH):
        j = i // 2
        x = layer_norm(DN_ALPHA * x + 0.5 * swiglu(x, ffn1_wg[i], ffn1_wu[i], ffn1_wd[i]), ln_g[i, 0], ln_b[i, 0])
        if i % 2 == 0:
            y = mixer_ab(x, ab_w_in[j], a_sinks[j], b_conv_w[j], b_conv_b[j],
                         b_wa[j], b_ba[j], b_wx[j], b_bx[j], b_lam[j], ab_w_out[j])
        else:
            y = mixer_c(x, c_w_in[j], c_conv_w[j], c_a_log[j], c_dt_bias[j], c_norm_g[j], c_w_out[j])
        x = layer_norm(DN_ALPHA * x + y, ln_g[i, 1], ln_b[i, 1])
        x = layer_norm(DN_ALPHA * x + 0.5 * swiglu(x, ffn2_wg[i], ffn2_wu[i], ffn2_wd[i]), ln_g[i, 2], ln_b[i, 2])
        x = x + jax.nn.sigmoid(x @ ple_wg[i] + ple_bg[i]) * (p[i] @ ple_wp[i])
    return x
```

```cpp
#include <hip/hip_runtime.h>
#include <hip/hip_cooperative_groups.h>
#include <cstdio>
namespace cg = cooperative_groups;

#ifndef MULTI_LAUNCH
#define MULTI_LAUNCH 0
#endif

#define LAS __attribute__((address_space(3)))
typedef unsigned short bf16_t;
typedef short bf16x8 __attribute__((ext_vector_type(8)));
typedef float f32x4 __attribute__((ext_vector_type(4)));
typedef unsigned u32x4 __attribute__((ext_vector_type(4)));
typedef unsigned u32x2 __attribute__((ext_vector_type(2)));
typedef float f32x2 __attribute__((ext_vector_type(2)));
#define DI __device__ __forceinline__

constexpr int T_ = 65536, D_ = 1024, FF_ = 2816, SEQ_ = 2048;
constexpr int NTHREADS = 512;
constexpr int LDS_BYTES = 153600;
constexpr float DN_ALPHA = 1.41421356237f;

constexpr size_t MiB = 1ull << 20;
constexpr size_t SZ_UP = 5632ull * 1024 * 2, SZ_DN = 1024ull * 2816 * 2;
constexpr size_t W_FFN = 0;
constexpr size_t W_PLE = 4 * (SZ_UP + SZ_DN);
constexpr size_t SZ_PLE = 2097152 + 524288;
constexpr size_t W_AB_IN = W_PLE + 2 * SZ_PLE;
constexpr size_t W_AB_OUT = W_AB_IN + 1792ull * 1024 * 2;
constexpr size_t W_C_IN = W_AB_OUT + 2097152;
constexpr size_t W_C_OUT = W_C_IN + 4352ull * 1024 * 2;
constexpr size_t W_WA = W_C_OUT + 2097152;
constexpr size_t W_WX = W_WA + 65536;
constexpr size_t W_END = W_WX + 65536;
static_assert(W_END <= 96 * MiB, "weights region");
constexpr size_t WS_XB0 = 96 * MiB, WS_PB = 352 * MiB, WS_BIG = 384 * MiB;
constexpr size_t WS_GB = 88 * MiB;
constexpr size_t WS_NEED = 896 * MiB;
static_assert(W_END <= WS_GB, "gb placement");

struct Params {
    const float* in[29];
    float* out;
    unsigned char* ws;
    int ph_lo, ph_hi;
};

DI int otid() { int t = threadIdx.x; asm volatile("" : "+v"(t)); return t; }
DI unsigned f2bf(float f) { unsigned u = __float_as_uint(f); u += 0x7FFFu + ((u >> 16) & 1u); return u >> 16; }
DI unsigned pk2(float lo, float hi) { return f2bf(lo) | (f2bf(hi) << 16); }
DI float bf2f(unsigned b) { return __uint_as_float(b << 16); }
DI float bflo(unsigned w) { return __uint_as_float(w << 16); }
DI float bfhi(unsigned w) { return __uint_as_float(w & 0xffff0000u); }
DI unsigned cvt_pk_bf16(float lo, float hi) { unsigned r; asm volatile("v_cvt_pk_bf16_f32 %0, %1, %2" : "=v"(r) : "v"(lo), "v"(hi)); return r; }
DI float sigmoidf_(float x) { return __builtin_amdgcn_rcpf(1.0f + __expf(-x)); }
DI float siluf_(float x) { return x * __builtin_amdgcn_rcpf(1.0f + __expf(-x)); }
DI float log1p_fast(float e) { return e < 0.03125f ? e * (1.0f - e * (0.5f - e * (0.33333334f - 0.25f * e))) : __logf(1.0f + e); }
DI float softplusf_(float x) { return x > 20.0f ? x : log1p_fast(__expf(x)); }
DI float expm1_neg(float y) { return y > -0.03125f ? y * (1.0f + 0.5f * y * (1.0f + 0.33333334f * y * (1.0f + 0.25f * y))) : __expf(y) - 1.0f; }
DI float gelu_tanh(float x) { const float u = 0.7978845608028654f * (x + 0.044715f * x * x * x); const float e = __expf(-2.0f * fabsf(u)); const float t = (1.0f - e) / (1.0f + e); return 0.5f * x * (1.0f + (u < 0.f ? -t : t)); }
DI void lds_barrier() { asm volatile("s_waitcnt lgkmcnt(0)" ::: "memory"); __builtin_amdgcn_s_barrier(); asm volatile("" ::: "memory"); }
DI bf16x8 ldsfrag(const LAS unsigned char* p) { return *(const LAS bf16x8*)p; }
#define MFMA16(a, b, c) __builtin_amdgcn_mfma_f32_16x16x32_bf16((a), (b), (c), 0, 0, 0)

namespace pg8 {
constexpr int BM = 256, BK = 64, HALF = 128, HTB = HALF * BK * 2, STAGE_BYTES = 8 * HTB, NXCD = 8, WGM = 8;
DI int lds_byte(int r, int c) { const int st = (r >> 4) * 2 + (c >> 5), rr = r & 15, cc = c & 31, ob = rr * 64 + cc * 2; return st * 1024 + (ob ^ (((ob >> 9) & 1) << 5)); }
DI void stage_rc(int b, int& R, int& C) { const int st = b / 1024, sb = b % 1024, swz = sb ^ (((sb >> 9) & 1) << 5); R = (st >> 1) * 16 + swz / 64; C = (st & 1) * 32 + (swz % 64) / 2; }
DI int perm32(int rho) { const int n = rho >> 4, i = rho & 15; return 8 * (i >> 2) + 4 * n + (i & 3); }
struct Unit { int pm, pn; };
struct Gemm { const bf16_t* A; const bf16_t* Bt; int M, N, K, lda; };
struct StaticOrder {
    int nM, nN, nwg, G, c;
    DI void init(int M, int N, int G_, int c_) { nM = M / BM; nN = N / BM; nwg = nM * nN; G = G_; c = c_; }
    DI bool next(int i, Unit& u) const {
        const long L = (long)i * G + c; if (L >= nwg) return false;
        int wgid = (int)L; { const int q = nwg / NXCD, r = nwg % NXCD, xcd = wgid % NXCD, off = wgid / NXCD; wgid = (xcd < r ? xcd * (q + 1) : r * (q + 1) + (xcd - r) * q) + off; }
        const int nig = WGM * nN, gid = wgid / nig, fm = gid * WGM, gsz = (nM - fm) < WGM ? (nM - fm) : WGM;
        u.pm = fm + ((wgid % nig) % gsz); u.pn = (wgid % nig) / gsz; return true;
    }
};

template <class Epi, bool ALIGN_EPI = true, bool SP2 = true>
DI void gemm_phase(LAS unsigned char* lds, const Gemm g, const StaticOrder& S, const Epi& E) {
    const int tid = otid(), wid = __builtin_amdgcn_readfirstlane(tid >> 6), lane = tid & 63, wr = wid >> 2, wc = wid & 3, fr = lane & 15, fq = lane >> 4;
    const int K = g.K, nt = K / BK;
    unsigned voffA[2], voffB[2];
#pragma unroll
    for (int i = 0; i < 2; ++i) { int R, C; stage_rc(tid * 16 + i * 8192, R, C); const int Rb = Epi::PERM ? ((R & ~31) + perm32(R & 31)) : R;
        voffA[i] = (unsigned)(R * g.lda + C) * 2u; voffB[i] = (unsigned)(Rb * K + C) * 2u; }
    const size_t kstep = (size_t)(BK * 2);
    const size_t hstep = (size_t)HALF * K * 2;
    const size_t tstep = 2 * hstep;
    const size_t hstepA = (size_t)HALF * g.lda * 2, tstepA = 2 * hstepA;
    const unsigned ldsw = (unsigned)wid * 1024u;
    const int aoff = lds_byte(wr * 64 + fr, fq * 8), boff = lds_byte(wc * 32 + fr, fq * 8);
#define PG8_SA(b, h) (((b) * 2 + (h)) * HTB)
#define PG8_SB(b, h) ((4 + (b) * 2 + (h)) * HTB)
#define PG8_STAGE(bufoff, gbase, voff) do { const __attribute__((address_space(1))) char* _gb = (const __attribute__((address_space(1))) char*)(gbase); asm volatile("" : "+s"(_gb));   \
        _Pragma("unroll") for (int _i = 0; _i < 2; ++_i) { unsigned _vo = (voff)[_i]; asm volatile("" : "+v"(_vo));   \
        __builtin_amdgcn_global_load_lds((const __attribute__((address_space(1))) unsigned*)(_gb + _vo), (LAS unsigned*)(lds + (bufoff) + ldsw + _i * 8192), 16, 0, 0); } } while (0)
#define PG8_LDA(dst, b, h) do { _Pragma("unroll") for (int m = 0; m < 4; ++m) _Pragma("unroll") for (int k = 0; k < 2; ++k) dst[m][k] = *(const LAS bf16x8*)(lds + PG8_SA(b, h) + aoff + m * 2048 + k * 1024); } while (0)
#define PG8_LDB(dst, b, h) do { _Pragma("unroll") for (int n = 0; n < 2; ++n) _Pragma("unroll") for (int k = 0; k < 2; ++k) dst[n][k] = *(const LAS bf16x8*)(lds + PG8_SB(b, h) + boff + n * 2048 + k * 1024); } while (0)
#define PG8_MMA(ai, bj, At, Bt) do { __builtin_amdgcn_s_setprio(1); _Pragma("unroll") for (int m = 0; m < 4; ++m) _Pragma("unroll") for (int n = 0; n < 2; ++n) _Pragma("unroll") for (int k = 0; k < 2; ++k) \
        acc[ai][bj][m][n] = __builtin_amdgcn_mfma_f32_16x16x32_bf16(Bt[n][k], At[m][k], acc[ai][bj][m][n], 0, 0, 0); __builtin_amdgcn_s_setprio(0); } while (0)
#define PG8_WAIT_V(n) asm volatile("s_waitcnt vmcnt(" #n ")" ::: "memory")
#define PG8_WAIT_L(n) asm volatile("s_waitcnt lgkmcnt(" #n ")" ::: "memory")
#define PG8_BAR __builtin_amdgcn_s_barrier()
#define PG8_SCHED __builtin_amdgcn_sched_barrier(0)
    Unit cur, nxt; int ui = 0;
    if (!S.next(0, cur)) return;
    f32x4 acc[2][2][4][2];
#pragma unroll
    for (int a = 0; a < 2; ++a)
#pragma unroll
        for (int b = 0; b < 2; ++b)
#pragma unroll
            for (int m = 0; m < 4; ++m)
#pragma unroll
                for (int n = 0; n < 2; ++n) acc[a][b][m][n] = (f32x4){0.f, 0.f, 0.f, 0.f};
    bf16x8 At[4][2], B0[2][2], B1[2][2];
    const char* cA = (const char*)g.A + (size_t)cur.pm * tstepA; const char* cB = (const char*)g.Bt + (size_t)cur.pn * tstep;
    if constexpr (SP2) {
        PG8_STAGE(PG8_SB(0, 0), cB, voffB); PG8_STAGE(PG8_SB(0, 1), cB + hstep, voffB); PG8_STAGE(PG8_SA(0, 0), cA, voffA); PG8_STAGE(PG8_SA(0, 1), cA + hstepA, voffA);
        if (wr == 1) PG8_BAR;
        PG8_WAIT_V(2); PG8_BAR;
        PG8_STAGE(PG8_SB(1, 0), cB + kstep, voffB); PG8_STAGE(PG8_SA(1, 0), cA + kstep, voffA); PG8_STAGE(PG8_SB(1, 1), cB + hstep + kstep, voffB);
        PG8_WAIT_V(6); PG8_BAR;
    } else {
        PG8_STAGE(PG8_SB(0, 0), cB, voffB); PG8_STAGE(PG8_SA(0, 0), cA, voffA); PG8_STAGE(PG8_SB(0, 1), cB + hstep, voffB); PG8_STAGE(PG8_SA(0, 1), cA + hstepA, voffA);
        if (wr == 1) PG8_BAR;
        PG8_WAIT_V(4); PG8_BAR;
        PG8_STAGE(PG8_SB(1, 0), cB + kstep, voffB); PG8_STAGE(PG8_SA(1, 0), cA + kstep, voffA); PG8_STAGE(PG8_SB(1, 1), cB + hstep + kstep, voffB);
        PG8_WAIT_V(6); PG8_BAR;
    }
    for (;;) {
        const bool has_next = S.next(ui + 1, nxt);
        const char* nA = has_next ? (const char*)g.A + (size_t)nxt.pm * tstepA : cA; const char* nB = has_next ? (const char*)g.Bt + (size_t)nxt.pn * tstep : cB;
        for (int t = 0; t < nt; t += 2) {
            const bool last = (t == nt - 2);
            const char* a1 = cA + (size_t)(t + 1) * kstep;
            const char* a2 = last ? nA : cA + (size_t)(t + 2) * kstep; const char* b2 = last ? nB : cB + (size_t)(t + 2) * kstep;
            const char* a3 = a2 + kstep; const char* b3 = b2 + kstep;
            if constexpr (SP2) {
            PG8_LDB(B0, 0, 0); PG8_LDB(B1, 0, 1); PG8_SCHED; PG8_LDA(At, 0, 0); PG8_STAGE(PG8_SA(1, 1), a1 + hstepA, voffA);
            PG8_WAIT_V(8); PG8_WAIT_L(0); PG8_BAR; PG8_MMA(0, 0, At, B0); PG8_MMA(0, 1, At, B1); PG8_BAR; PG8_SCHED;
            PG8_LDA(At, 0, 1); PG8_STAGE(PG8_SB(0, 0), b2, voffB); PG8_STAGE(PG8_SB(0, 1), b2 + hstep, voffB); PG8_STAGE(PG8_SA(0, 0), a2, voffA);
            PG8_WAIT_V(8); PG8_WAIT_L(0); PG8_BAR; PG8_MMA(1, 0, At, B0); PG8_MMA(1, 1, At, B1); PG8_BAR; PG8_SCHED;
            PG8_LDB(B0, 1, 0); PG8_LDB(B1, 1, 1); PG8_SCHED; PG8_LDA(At, 1, 0); PG8_STAGE(PG8_SA(0, 1), a2 + hstepA, voffA);
            PG8_WAIT_V(8); PG8_WAIT_L(0); PG8_BAR; PG8_MMA(0, 0, At, B0); PG8_MMA(0, 1, At, B1); PG8_BAR; PG8_SCHED;
            PG8_LDA(At, 1, 1); PG8_STAGE(PG8_SB(1, 0), b3, voffB); PG8_STAGE(PG8_SB(1, 1), b3 + hstep, voffB); PG8_STAGE(PG8_SA(1, 0), a3, voffA);
            PG8_WAIT_V(8); PG8_WAIT_L(0); PG8_BAR; PG8_MMA(1, 0, At, B0); PG8_MMA(1, 1, At, B1); PG8_BAR; PG8_SCHED;
            } else {
            PG8_LDB(B0, 0, 0); PG8_SCHED; PG8_LDA(At, 0, 0); PG8_STAGE(PG8_SA(1, 1), a1 + hstepA, voffA);
            PG8_WAIT_L(8); PG8_BAR; PG8_WAIT_L(0); PG8_MMA(0, 0, At, B0); PG8_BAR; PG8_SCHED;
            PG8_LDB(B1, 0, 1); PG8_STAGE(PG8_SB(0, 0), b2, voffB);
            PG8_BAR; PG8_WAIT_L(0); PG8_MMA(0, 1, At, B1); PG8_BAR;
            PG8_LDA(At, 0, 1); PG8_STAGE(PG8_SA(0, 0), a2, voffA);
            PG8_BAR; PG8_WAIT_L(0); PG8_MMA(1, 0, At, B0); PG8_BAR; PG8_SCHED;
            PG8_STAGE(PG8_SB(0, 1), b2 + hstep, voffB);
            PG8_WAIT_V(6); PG8_BAR; PG8_MMA(1, 1, At, B1); PG8_BAR;
            PG8_LDB(B0, 1, 0); PG8_SCHED; PG8_LDA(At, 1, 0); PG8_STAGE(PG8_SA(0, 1), a2 + hstepA, voffA);
            PG8_WAIT_L(8); PG8_BAR; PG8_WAIT_L(0); PG8_MMA(0, 0, At, B0); PG8_BAR; PG8_SCHED;
            PG8_LDB(B1, 1, 1); PG8_STAGE(PG8_SB(1, 0), b3, voffB);
            PG8_BAR; PG8_WAIT_L(0); PG8_MMA(0, 1, At, B1); PG8_BAR;
            PG8_LDA(At, 1, 1); PG8_STAGE(PG8_SA(1, 0), a3, voffA);
            PG8_BAR; PG8_WAIT_L(0); PG8_MMA(1, 0, At, B0); PG8_BAR; PG8_SCHED;
            PG8_STAGE(PG8_SB(1, 1), b3 + hstep, voffB);
            PG8_WAIT_V(6); PG8_BAR; PG8_MMA(1, 1, At, B1); PG8_BAR;
            }
        }
        if constexpr (ALIGN_EPI) { if (wr == 0) PG8_BAR; }
        { const int t2 = otid(), l2 = t2 & 63; E(acc, cur, wr, (t2 >> 6) & 3, l2 & 15, l2 >> 4); }
        if (!has_next) break;
#pragma unroll
        for (int a = 0; a < 2; ++a)
#pragma unroll
            for (int b = 0; b < 2; ++b)
#pragma unroll
                for (int m = 0; m < 4; ++m)
#pragma unroll
                    for (int n = 0; n < 2; ++n) acc[a][b][m][n] = (f32x4){0.f, 0.f, 0.f, 0.f};
        cur = nxt; cA = nA; cB = nB; ++ui;
        if constexpr (ALIGN_EPI) { if (wr == 1) PG8_BAR; }
    }
    PG8_WAIT_V(0);
    if constexpr (!ALIGN_EPI) { if (wr == 0) PG8_BAR; }
    PG8_BAR;
#undef PG8_SA
#undef PG8_SB
#undef PG8_STAGE
#undef PG8_LDA
#undef PG8_LDB
#undef PG8_MMA
#undef PG8_WAIT_V
#undef PG8_WAIT_L
#undef PG8_BAR
#undef PG8_SCHED
}
}

struct EpiSwiglu {
    static constexpr bool PERM = true;
    bf16_t* H;
    DI void operator()(const f32x4 (&acc)[2][2][4][2], const pg8::Unit& u, int wr, int wc, int fr, int fq) const {
        const int row0 = u.pm * 256 + wr * 64 + fr, col0 = u.pn * 128 + wc * 32 + 8 * fq;
#pragma unroll
        for (int ai = 0; ai < 2; ++ai)
#pragma unroll
            for (int m = 0; m < 4; ++m) {
                bf16_t* rowp = H + (size_t)(row0 + ai * 128 + m * 16) * FF_ + col0;
                float h[8];
#pragma unroll
                for (int n = 0; n < 2; ++n)
#pragma unroll
                    for (int j = 0; j < 4; ++j) { const float gg = acc[ai][0][m][n][j], uu = acc[ai][1][m][n][j]; h[n * 4 + j] = siluf_(gg) * uu; }
                u32x4 w; w.x = cvt_pk_bf16(h[0], h[1]); w.y = cvt_pk_bf16(h[2], h[3]); w.z = cvt_pk_bf16(h[4], h[5]); w.w = cvt_pk_bf16(h[6], h[7]);
                *(u32x4*)rowp = w;
            }
    }
};
template <bool HAS_RES> struct EpiResid {
    static constexpr bool PERM = false;
    const float* res; bf16_t* out; const bf16_t* resb; int half;
    DI void operator()(const f32x4 (&acc)[2][2][4][2], const pg8::Unit& u, int wr, int wc, int fr, int fq) const {
        const int row0 = u.pm * 256 + wr * 64 + fr, col0 = u.pn * 256 + wc * 32 + 4 * fq;
#pragma unroll
        for (int ai = 0; ai < 2; ++ai)
#pragma unroll
            for (int m = 0; m < 4; ++m) {
                const size_t off = (size_t)(row0 + ai * 128 + m * 16) * D_ + col0;
#pragma unroll
                for (int bj = 0; bj < 2; ++bj)
#pragma unroll
                    for (int n = 0; n < 2; ++n) {
                        const size_t o = off + bj * 128 + n * 16;
                        f32x4 v = acc[ai][bj][m][n] * (half ? 0.5f : 1.0f);
                        if (HAS_RES) {
                            f32x4 r;
                            if (resb) { const u32x2 rb = *(const u32x2*)(resb + o); r = (f32x4){bflo(rb.x), bfhi(rb.x), bflo(rb.y), bfhi(rb.y)}; }
                            else r = *(const f32x4*)(res + o);
                            v = v + r * DN_ALPHA;
                        }
                        { u32x2 w; w.x = cvt_pk_bf16(v[0], v[1]); w.y = cvt_pk_bf16(v[2], v[3]); *(u32x2*)(out + o) = w; }
                    }
            }
    }
};
struct EpiProj {
    static constexpr bool PERM = true;
    bf16_t* O; int ldc; int n_main; float* gb;
    DI void operator()(const f32x4 (&acc)[2][2][4][2], const pg8::Unit& u, int wr, int wc, int fr, int fq) const {
        const int row0 = u.pm * 256 + wr * 64 + fr;
        if (u.pn < n_main) {
            const int col0 = u.pn * 256 + wc * 32 + 8 * fq;
#pragma unroll
            for (int ai = 0; ai < 2; ++ai)
#pragma unroll
                for (int m = 0; m < 4; ++m) {
                    bf16_t* rowp = O + (size_t)(row0 + ai * 128 + m * 16) * ldc + col0;
#pragma unroll
                    for (int bj = 0; bj < 2; ++bj) {
                        const f32x4 v0 = acc[ai][bj][m][0], v1 = acc[ai][bj][m][1];
                        u32x4 w; w.x = cvt_pk_bf16(v0[0], v0[1]); w.y = cvt_pk_bf16(v0[2], v0[3]); w.z = cvt_pk_bf16(v1[0], v1[1]); w.w = cvt_pk_bf16(v1[2], v1[3]);
                        *(u32x4*)(rowp + bj * 128) = w;
                    }
                }
        } else if (wc == 0 && fq < 2) {
#pragma unroll
            for (int ai = 0; ai < 2; ++ai)
#pragma unroll
                for (int m = 0; m < 4; ++m) {
                    float* rp = gb + (size_t)(row0 + ai * 128 + m * 16) * 16 + 8 * fq;
                    *(f32x4*)rp = acc[ai][0][m][0]; *(f32x4*)(rp + 4) = acc[ai][0][m][1];
                }
        }
    }
};
struct EpiPle {
    static constexpr bool PERM = true;
    const bf16_t* xb; const bf16_t* pp; const float* bg; float* out; bf16_t* xbn;
    DI void operator()(const f32x4 (&acc)[2][2][4][2], const pg8::Unit& u, int wr, int wc, int fr, int fq) const {
        const int row0 = u.pm * 256 + wr * 64 + fr, col0 = u.pn * 256 + wc * 32 + 8 * fq;
#pragma unroll
        for (int ai = 0; ai < 2; ++ai)
#pragma unroll
            for (int m = 0; m < 4; ++m) {
                const size_t off = (size_t)(row0 + ai * 128 + m * 16) * D_ + col0;
#pragma unroll
                for (int bj = 0; bj < 2; ++bj) {
                    const size_t o = off + bj * 128;
                    const f32x4 b0 = *(const f32x4*)(bg + col0 + bj * 128), b1 = *(const f32x4*)(bg + col0 + bj * 128 + 4);
                    const u32x4 rb = *(const u32x4*)(xb + o);
                    const u32x4 pb = *(const u32x4*)(pp + o);
                    const f32x4 x0 = (f32x4){bflo(rb.x), bfhi(rb.x), bflo(rb.y), bfhi(rb.y)}, x1 = (f32x4){bflo(rb.z), bfhi(rb.z), bflo(rb.w), bfhi(rb.w)};
                    const f32x4 p0 = (f32x4){bflo(pb.x), bfhi(pb.x), bflo(pb.y), bfhi(pb.y)}, p1 = (f32x4){bflo(pb.z), bfhi(pb.z), bflo(pb.w), bfhi(pb.w)};
                    f32x4 v0, v1;
#pragma unroll
                    for (int j = 0; j < 4; ++j) { v0[j] = x0[j] + sigmoidf_(acc[ai][bj][m][0][j] + b0[j]) * p0[j]; v1[j] = x1[j] + sigmoidf_(acc[ai][bj][m][1][j] + b1[j]) * p1[j]; }
                    *(f32x4*)(out + o) = v0; *(f32x4*)(out + o + 4) = v1;
                    if (xbn) { u32x4 w; w.x = cvt_pk_bf16(v0[0], v0[1]); w.y = cvt_pk_bf16(v0[2], v0[3]); w.z = cvt_pk_bf16(v1[0], v1[1]); w.w = cvt_pk_bf16(v1[2], v1[3]); *(u32x4*)(xbn + o) = w; }
                }
            }
    }
};

DI void conv_plain(const float* src, bf16_t* dst, size_t n) {
    const size_t stride = (size_t)gridDim.x * NTHREADS * 8;
    for (size_t i = ((size_t)blockIdx.x * NTHREADS + otid()) * 8; i < n; i += stride) {
        const f32x4 a = *(const f32x4*)(src + i), b = *(const f32x4*)(src + i + 4);
        u32x4 w; w.x = pk2(a[0], a[1]); w.y = pk2(a[2], a[3]); w.z = pk2(b[0], b[1]); w.w = pk2(b[2], b[3]);
        *(u32x4*)(dst + i) = w;
    }
}
DI void conv_T(const float* src, int K, int N, bf16_t* dst, int grp, int gstride, int goff, LAS float* tile) {
    const int tid = otid();
    const int ntn = (N + 63) / 64, ntk = K / 64, ntile = ntn * ntk;
    const int kk0 = tid >> 4, n4 = (tid & 15) * 4;
    f32x4 v[2];
    int t = blockIdx.x;
    if (t < ntile) {
        const int k0 = (t / ntn) * 64, n = (t % ntn) * 64 + n4;
#pragma unroll
        for (int p = 0; p < 2; ++p) v[p] = (n < N) ? *(const f32x4*)(src + (size_t)(k0 + kk0 + 32 * p) * N + n) : (f32x4){0.f, 0.f, 0.f, 0.f};
    }
    for (; t < ntile; t += gridDim.x) {
        const int k0 = (t / ntn) * 64, n0 = (t % ntn) * 64;
#pragma unroll
        for (int p = 0; p < 2; ++p) {
            const int kk = kk0 + 32 * p;
            tile[kk * 65 + n4 + 0] = v[p][0]; tile[kk * 65 + n4 + 1] = v[p][1]; tile[kk * 65 + n4 + 2] = v[p][2]; tile[kk * 65 + n4 + 3] = v[p][3];
        }
        const int tn_ = t + gridDim.x;
        if (tn_ < ntile) {
            const int k1 = (tn_ / ntn) * 64, n = (tn_ % ntn) * 64 + n4;
#pragma unroll
            for (int p = 0; p < 2; ++p) v[p] = (n < N) ? *(const f32x4*)(src + (size_t)(k1 + kk0 + 32 * p) * N + n) : (f32x4){0.f, 0.f, 0.f, 0.f};
        }
        lds_barrier();
        {
            const int nn = tid >> 3, k8 = (tid & 7) * 8, n = n0 + nn;
            if (n < N) {
                float x[8];
#pragma unroll
                for (int j = 0; j < 8; ++j) x[j] = tile[(k8 + j) * 65 + nn];
                u32x4 w; w.x = pk2(x[0], x[1]); w.y = pk2(x[2], x[3]); w.z = pk2(x[4], x[5]); w.w = pk2(x[6], x[7]);
                const size_t row = (size_t)(n / grp) * gstride + (n % grp) + goff;
                *(u32x4*)(dst + row * K + k0 + k8) = w;
            }
        }
        lds_barrier();
    }
}

DI void phase_convert(const Params& P, LAS unsigned char* lds) {
    LAS float* tile = (LAS float*)lds;
    bf16_t* W = (bf16_t*)P.ws;
    for (int l = 0; l < 2; ++l)
        for (int w = 0; w < 2; ++w) {
            bf16_t* up = (bf16_t*)(P.ws + W_FFN + (size_t)(l * 2 + w) * (SZ_UP + SZ_DN));
            bf16_t* dn = (bf16_t*)((unsigned char*)up + SZ_UP);
            const float* wg = P.in[w ? 5 : 2] + (size_t)l * D_ * FF_;
            const float* wu = P.in[w ? 6 : 3] + (size_t)l * D_ * FF_;
            const float* wd = P.in[w ? 7 : 4] + (size_t)l * FF_ * D_;
            conv_T(wg, D_, FF_, up, 128, 256, 0, tile);
            conv_T(wu, D_, FF_, up, 128, 256, 128, tile);
            conv_T(wd, FF_, D_, dn, 1 << 30, 0, 0, tile);
        }
    for (int l = 0; l < 2; ++l) {
        bf16_t* g = (bf16_t*)(P.ws + W_PLE + (size_t)l * SZ_PLE);
        bf16_t* pw = (bf16_t*)((unsigned char*)g + 2097152);
        conv_T(P.in[10] + (size_t)l * D_ * D_, D_, D_, g, 1 << 30, 0, 0, tile);
        conv_T(P.in[12] + (size_t)l * 256 * D_, 256, D_, pw, 1 << 30, 0, 0, tile);
    }
    conv_T(P.in[13], D_, 1792, (bf16_t*)(P.ws + W_AB_IN), 1 << 30, 0, 0, tile);
    conv_T(P.in[22], D_, D_, (bf16_t*)(P.ws + W_AB_OUT), 1 << 30, 0, 0, tile);
    conv_T(P.in[23], D_, 4112, (bf16_t*)(P.ws + W_C_IN), 1 << 30, 0, 0, tile);
    conv_T(P.in[28], D_, D_, (bf16_t*)(P.ws + W_C_OUT), 1 << 30, 0, 0, tile);
    for (int hb = 0; hb < 8; ++hb) {
        conv_T(P.in[17] + hb * 4096, 64, 64, (bf16_t*)(P.ws + W_WA) + hb * 4096, 1 << 30, 0, 0, tile);
        conv_T(P.in[19] + hb * 4096, 64, 64, (bf16_t*)(P.ws + W_WX) + hb * 4096, 1 << 30, 0, 0, tile);
    }
    conv_plain(P.in[0], (bf16_t*)(P.ws + WS_XB0), (size_t)T_ * D_);
    conv_plain(P.in[1], (bf16_t*)(P.ws + WS_PB), (size_t)T_ * 256);
    (void)W;
}

template <int CTRL> DI float dppf(float v) { return __builtin_bit_cast(float, __builtin_amdgcn_update_dpp(0, __builtin_bit_cast(int, v), CTRL, 0xF, 0xF, true)); }
DI float row16_sum(float v) { v += dppf<0xB1>(v); v += dppf<0x4E>(v); v += dppf<0x141>(v); v += dppf<0x140>(v); return v; }
DI float row16_max(float v) { v = fmaxf(v, dppf<0xB1>(v)); v = fmaxf(v, dppf<0x4E>(v)); v = fmaxf(v, dppf<0x141>(v)); v = fmaxf(v, dppf<0x140>(v)); return v; }
DI float rdlane(float v, int l) { return __builtin_bit_cast(float, __builtin_amdgcn_readlane(__builtin_bit_cast(int, v), l)); }
DI float wave_sum(float v) { v = row16_sum(v); return (rdlane(v, 0) + rdlane(v, 16)) + (rdlane(v, 32) + rdlane(v, 48)); }
DI void phase_ln(const bf16_t* vin, float* xf, bf16_t* xb, const float* g, const float* b, bool write_f32) {
    const int tid = otid(), wave = tid >> 6, lane = tid & 63;
    f32x4 gv[4], bv[4];
#pragma unroll
    for (int i = 0; i < 4; ++i) { gv[i] = *(const f32x4*)(g + i * 256 + lane * 4); bv[i] = *(const f32x4*)(b + i * 256 + lane * 4); }
    const int nw = gridDim.x * 8;
    constexpr int R = 4;
    for (int r0 = blockIdx.x * 8 + wave; r0 < T_; r0 += nw * R) {
        f32x4 v[R][4];
#pragma unroll
        for (int k = 0; k < R; ++k) {
            const bf16_t* row = vin + (size_t)(r0 + k * nw) * D_;
#pragma unroll
            for (int i = 0; i < 4; ++i) { const u32x2 w = *(const u32x2*)(row + i * 256 + lane * 4); v[k][i] = (f32x4){bflo(w.x), bfhi(w.x), bflo(w.y), bfhi(w.y)}; }
        }
#pragma unroll
        for (int k = 0; k < R; ++k) {
            float s = 0.f;
#pragma unroll
            for (int i = 0; i < 4; ++i) s += (v[k][i][0] + v[k][i][1]) + (v[k][i][2] + v[k][i][3]);
            const float mean = wave_sum(s) * (1.0f / 1024.0f);
            float q = 0.f;
#pragma unroll
            for (int i = 0; i < 4; ++i) { const f32x4 d = v[k][i] - mean; q += (d[0] * d[0] + d[1] * d[1]) + (d[2] * d[2] + d[3] * d[3]); }
            const float rstd = rsqrtf(wave_sum(q) * (1.0f / 1024.0f) + 1e-5f);
            float* row = xf + (size_t)(r0 + k * nw) * D_;
            bf16_t* rb = xb + (size_t)(r0 + k * nw) * D_;
#pragma unroll
            for (int i = 0; i < 4; ++i) {
                const f32x4 o = (v[k][i] - mean) * rstd * gv[i] + bv[i];
                if (write_f32) *(f32x4*)(row + i * 256 + lane * 4) = o;
                u32x2 w; w.x = pk2(o[0], o[1]); w.y = pk2(o[2], o[3]);
                *(u32x2*)(rb + i * 256 + lane * 4) = w;
            }
        }
    }
}

constexpr int PJ0 = 1792;
DI void attn_unit(const bf16_t* proj, bf16_t* ycat, const float* sinks, int b, int n, int kvh, LAS unsigned char* lds) {
    constexpr int KS_OFF = 0, VT_OFF = 27648, PS_OFF = 53248;
    const int tid = otid(), wave = tid >> 6, lane = tid & 63, fr = lane & 15, fq = lane >> 4;
    u32x4 kva[3], vva[3];
#pragma unroll
    for (int it = 0; it < 3; ++it) {
        const int idx = tid + NTHREADS * it, s = idx >> 3, d8 = idx & 7;
        const int pos = (n - 2) * 64 + s;
        kva[it] = (u32x4){0u, 0u, 0u, 0u}; vva[it] = (u32x4){0u, 0u, 0u, 0u};
        if (pos >= 0) {
            const bf16_t* rp = proj + (size_t)(b * SEQ_ + pos) * PJ0;
            kva[it] = *(const u32x4*)(rp + 512 + kvh * 64 + d8 * 8);
            vva[it] = *(const u32x4*)(rp + 640 + kvh * 64 + d8 * 8);
        }
    }
    bf16x8 qall[2][2];
    {
        const int g_ = wave >> 1, hh_ = kvh * 4 + g_, rh_ = wave & 1;
#pragma unroll
        for (int rt = 0; rt < 2; ++rt)
#pragma unroll
            for (int ks = 0; ks < 2; ++ks)
                qall[rt][ks] = *(const bf16x8*)(proj + (size_t)(b * SEQ_ + n * 64 + rh_ * 32 + rt * 16 + fr) * PJ0 + hh_ * 64 + ks * 32 + fq * 8);
    }
#pragma unroll
    for (int it = 0; it < 3; ++it) {
        const int idx = tid + NTHREADS * it, s = idx >> 3, d8 = idx & 7;
        const u32x4 kv = kva[it], vv = vva[it];
        *(LAS u32x4*)(lds + KS_OFF + s * 144 + d8 * 16) = kv;
        const unsigned vw[4] = {vv.x, vv.y, vv.z, vv.w};
#pragma unroll
        for (int j = 0; j < 4; ++j) {
            *(LAS bf16_t*)(lds + VT_OFF + (d8 * 8 + 2 * j) * 400 + s * 2) = (bf16_t)(vw[j] & 0xffffu);
            *(LAS bf16_t*)(lds + VT_OFF + (d8 * 8 + 2 * j + 1) * 400 + s * 2) = (bf16_t)(vw[j] >> 16);
        }
    }
    __syncthreads();
    const int g = wave >> 1, hh = kvh * 4 + g, rh = wave & 1;
    const float slope = exp2f(-(float)(hh + 1)), sink = sinks[hh];
    LAS unsigned char* Ps = lds + PS_OFF + wave * 6400;
    for (int rt = 0; rt < 2; ++rt) {
        const int c0 = rh * 32 + rt * 16;
        bf16x8 qa[2];
#pragma unroll
        for (int ks = 0; ks < 2; ++ks) qa[ks] = (rt == 0) ? qall[0][ks] : qall[1][ks];
        f32x4 sc[12];
#pragma unroll
        for (int kt = 0; kt < 12; ++kt) {
            f32x4 a = (f32x4){0.f, 0.f, 0.f, 0.f};
#pragma unroll
            for (int ks = 0; ks < 2; ++ks) a = MFMA16(qa[ks], ldsfrag(lds + KS_OFF + (kt * 16 + fr) * 144 + (ks * 32 + fq * 8) * 2), a);
            sc[kt] = a;
        }
        float mx[4] = {-3.0e38f, -3.0e38f, -3.0e38f, -3.0e38f};
#pragma unroll
        for (int kt = 0; kt < 12; ++kt) {
            const int s = kt * 16 + fr;
            const bool valid = ((n - 2) * 64 + s) >= 0;
#pragma unroll
            for (int j = 0; j < 4; ++j) {
                const int c = c0 + fq * 4 + j;
                const float dist = fabsf((float)(c + 128 - s));
                const float v = valid ? (sc[kt][j] * 0.125f - slope * dist) : -3.0e38f;
                sc[kt][j] = v; mx[j] = fmaxf(mx[j], v);
            }
        }
        float den[4];
#pragma unroll
        for (int j = 0; j < 4; ++j) {
            float m = mx[j];
            m = row16_max(m);
            m = fmaxf(m, sink); mx[j] = m;
            float ssum = 0.f;
#pragma unroll
            for (int kt = 0; kt < 12; ++kt) { const float p = (sc[kt][j] > -1.0e38f) ? __expf(sc[kt][j] - m) : 0.f; sc[kt][j] = p; ssum += p; }
            ssum = row16_sum(ssum);
            den[j] = 1.0f / (ssum + __expf(sink - m));
        }
#pragma unroll
        for (int kt = 0; kt < 12; ++kt)
#pragma unroll
            for (int j = 0; j < 4; ++j) *(LAS bf16_t*)(Ps + (fq * 4 + j) * 400 + (kt * 16 + fr) * 2) = (bf16_t)f2bf(sc[kt][j] * den[j]);
        __syncthreads();
#pragma unroll
        for (int dt = 0; dt < 4; ++dt) {
            f32x4 o = (f32x4){0.f, 0.f, 0.f, 0.f};
#pragma unroll
            for (int ks = 0; ks < 6; ++ks)
                o = MFMA16(ldsfrag(Ps + fr * 400 + (ks * 32 + fq * 8) * 2), ldsfrag(lds + VT_OFF + (dt * 16 + fr) * 400 + (ks * 32 + fq * 8) * 2), o);
#pragma unroll
            for (int j = 0; j < 4; ++j)
                ycat[(size_t)(b * SEQ_ + n * 64 + c0 + fq * 4 + j) * D_ + hh * 64 + dt * 16 + fr] = (bf16_t)f2bf(o[j]);
        }
        __syncthreads();
    }
}

DI void rglru_unit(const Params& P, const bf16_t* proj, bf16_t* ycat, int b, int hb, LAS unsigned char* lds) {
    constexpr int WA_OFF = 0, WX_OFF = 9216, BXC_OFF = 18432, BXF_OFF = 27648, A_OFF = 44032, U_OFF = 60416;
    const int tid = otid(), wave = tid >> 6, lane = tid & 63, fr = lane & 15, fq = lane >> 4;
    {
        const int j = tid >> 3, c8 = tid & 7;
        *(LAS u32x4*)(lds + WA_OFF + j * 144 + c8 * 16) = *(const u32x4*)((const bf16_t*)(P.ws + W_WA) + hb * 4096 + j * 64 + c8 * 8);
        *(LAS u32x4*)(lds + WX_OFF + j * 144 + c8 * 16) = *(const u32x4*)((const bf16_t*)(P.ws + W_WX) + hb * 4096 + j * 64 + c8 * 8);
    }
    const int ch = tid & 63, tg = tid >> 6;
    float cw[4];
#pragma unroll
    for (int j = 0; j < 4; ++j) cw[j] = P.in[15][j * 512 + hb * 64 + ch];
    const float cb = P.in[16][hb * 64 + ch];
    const int tr = wave >> 1, ctb = 2 * (wave & 1);
    float ba[2], bxb[2], spl[2];
#pragma unroll
    for (int c = 0; c < 2; ++c) { const int cc = hb * 64 + (ctb + c) * 16 + fr; ba[c] = P.in[18][cc]; bxb[c] = P.in[20][cc]; spl[c] = softplusf_(-P.in[21][cc]); }
    float hstate = 0.f;
    LAS float* BXF = (LAS float*)(lds + BXF_OFF); LAS float* AA = (LAS float*)(lds + A_OFF); LAS float* UU = (LAS float*)(lds + U_OFF);
    unsigned rawn[11], bgrn[8];
#pragma unroll
    for (int i = 0; i < 11; ++i) { const int sp = tg * 8 - 3 + i; rawn[i] = (sp >= 0) ? (unsigned)proj[(size_t)(b * SEQ_ + sp) * PJ0 + 768 + hb * 64 + ch] : 0u; }
#pragma unroll
    for (int i = 0; i < 8; ++i) bgrn[i] = proj[(size_t)(b * SEQ_ + tg * 8 + i) * PJ0 + 1280 + hb * 64 + ch];
#pragma unroll 1
    for (int n = 0; n < 32; ++n) {
        const int t0 = b * SEQ_ + n * 64;
        float raw[11]; unsigned bgr[8];
#pragma unroll
        for (int i = 0; i < 11; ++i) raw[i] = bf2f(rawn[i]);
#pragma unroll
        for (int i = 0; i < 8; ++i) bgr[i] = bgrn[i];
        if (n + 1 < 32) {
#pragma unroll
            for (int i = 0; i < 11; ++i) rawn[i] = proj[(size_t)(t0 + 64 + tg * 8 - 3 + i) * PJ0 + 768 + hb * 64 + ch];
#pragma unroll
            for (int i = 0; i < 8; ++i) bgrn[i] = proj[(size_t)(t0 + 64 + tg * 8 + i) * PJ0 + 1280 + hb * 64 + ch];
        }
#pragma unroll
        for (int i = 0; i < 8; ++i) {
            const float v = cb + cw[0] * raw[i] + cw[1] * raw[i + 1] + cw[2] * raw[i + 2] + cw[3] * raw[i + 3];
            const int tok = tg * 8 + i;
            BXF[tok * 64 + ch] = v;
            *(LAS bf16_t*)(lds + BXC_OFF + tok * 144 + ch * 2) = (bf16_t)f2bf(v);
        }
        lds_barrier();
        {
            bf16x8 af[2];
#pragma unroll
            for (int ks = 0; ks < 2; ++ks) af[ks] = ldsfrag(lds + BXC_OFF + (tr * 16 + fr) * 144 + (ks * 32 + fq * 8) * 2);
#pragma unroll
            for (int c = 0; c < 2; ++c) {
                const int ct = ctb + c;
                f32x4 ga = (f32x4){0.f, 0.f, 0.f, 0.f}, gx = (f32x4){0.f, 0.f, 0.f, 0.f};
#pragma unroll
                for (int ks = 0; ks < 2; ++ks) {
                    ga = MFMA16(af[ks], ldsfrag(lds + WA_OFF + (ct * 16 + fr) * 144 + (ks * 32 + fq * 8) * 2), ga);
                    gx = MFMA16(af[ks], ldsfrag(lds + WX_OFF + (ct * 16 + fr) * 144 + (ks * 32 + fq * 8) * 2), gx);
                }
#pragma unroll
                for (int j = 0; j < 4; ++j) {
                    const int tok = tr * 16 + fq * 4 + j, cc = ct * 16 + fr;
                    const float r = sigmoidf_(ga[j] + ba[c]), ig = sigmoidf_(gx[j] + bxb[c]);
                    const float la = -8.0f * r * spl[c];
                    const float a = __expf(la);
                    const float mult = sqrtf(fmaxf(-expm1_neg(2.0f * la), 0.f));
                    AA[tok * 64 + cc] = a;
                    UU[tok * 64 + cc] = mult * ig * BXF[tok * 64 + cc];
                }
            }
        }
        lds_barrier();
        if (wave == 0) {
#pragma unroll 1
            for (int t8 = 0; t8 < 64; t8 += 8) {
                float av[8], uv[8];
#pragma unroll
                for (int k = 0; k < 8; ++k) { av[k] = AA[(t8 + k) * 64 + lane]; uv[k] = UU[(t8 + k) * 64 + lane]; }
                __builtin_amdgcn_sched_barrier(0);
#pragma unroll
                for (int k = 0; k < 8; ++k) { hstate = av[k] * hstate + uv[k]; uv[k] = hstate; }
#pragma unroll
                for (int k = 0; k < 8; ++k) UU[(t8 + k) * 64 + lane] = uv[k];
            }
        }
        lds_barrier();
#pragma unroll
        for (int i = 0; i < 8; ++i) {
            const int tok = tg * 8 + i;
            const float y = UU[tok * 64 + ch] * gelu_tanh(bf2f(bgr[i]));
            ycat[(size_t)(t0 + tok) * D_ + 512 + hb * 64 + ch] = (bf16_t)f2bf(y);
        }
    }
    __syncthreads();
}

DI void phase_mixer0(const Params& P, LAS unsigned char* lds, const bf16_t* proj, bf16_t* ycat) {
    for (int u = blockIdx.x; u < 256; u += gridDim.x) rglru_unit(P, proj, ycat, u >> 3, u & 7, lds);
    for (int u = blockIdx.x; u < 2048; u += gridDim.x) { const int kvh = u & 1, n = (u >> 1) & 31, b = u >> 6; attn_unit(proj, ycat, P.in[14], b, n, kvh, lds); }
}

constexpr int PJ1 = 4096;
DI void gdn_unit(const Params& P, bf16_t* proj, const float* gb, int b, int h, LAS unsigned char* lds) {
    constexpr int Q_OFF = 0, K_OFF = 17408, KT_OFF = 34816, X_OFF = 53248, ST_OFF = 90112, ATT_OFF = 124928, L_OFF = 134144, MISC_OFF = 150528;
    constexpr int VT_OFF = X_OFF, TP_OFF = X_OFF + 18432, TPP_OFF = X_OFF + 27648, VN_OFF = X_OFF, VNS_OFF = X_OFF + 18432;
    const int tid = otid(), wave = __builtin_amdgcn_readfirstlane(tid >> 6), lane0 = tid & 63;
    LAS float* Lm = (LAS float*)(lds + L_OFF);
    LAS float* gcs = (LAS float*)(lds + MISC_OFF); LAS float* betas = gcs + 64; LAS float* egcs = gcs + 128; LAS float* djs = gcs + 192; LAS float* part = gcs + 256;
    for (int i = tid; i < 34816 / 4; i += NTHREADS) *(LAS unsigned*)(lds + ST_OFF + i * 4) = 0u;
    f32x4 Sacc[8];
#pragma unroll
    for (int i = 0; i < 8; ++i) Sacc[i] = (f32x4){0.f, 0.f, 0.f, 0.f};
    const float Aneg = -__expf(P.in[25][h]), dtb = P.in[26][h];
    const float ng = P.in[27][16 * wave + (lane0 & 15)];
    const float* cwp = P.in[24] + h * 128 + 2 * lane0;
    __syncthreads();
    f32x2 cwr[3][4];
#pragma unroll
    for (int w = 0; w < 3; ++w)
#pragma unroll
        for (int j = 0; j < 4; ++j) cwr[w][j] = *(const f32x2*)(cwp + j * 3072 + w * 1024);
    unsigned rawq[3][11]; float gbl, gai;
    {
        const int t00 = b * SEQ_;
#pragma unroll
        for (int w = 0; w < 3; ++w) {
            const bf16_t* rbase = proj + (size_t)(t00 + wave * 8 - 3) * PJ1 + w * 1024 + h * 128;
#pragma unroll
            for (int i = 0; i < 11; ++i) rawq[w][i] = (wave * 8 - 3 + i >= 0) ? *(const unsigned*)(rbase + i * PJ1 + 2 * lane0) : 0u;
        }
        gbl = gb[(size_t)(t00 + lane0) * 16 + h]; gai = gb[(size_t)(t00 + lane0) * 16 + 8 + h];
    }
#pragma unroll 1
    for (int n = 0; n < 32; ++n) {
        int lane = lane0; asm volatile("" : "+v"(lane));
        const int fr = lane & 15, fq = lane >> 4;
        const int t0 = b * SEQ_ + n * 64;
        float beta, gc, gc_last, egc;
        {
            const float bl = gbl, ai = gai;
            beta = sigmoidf_(bl);
            gc = Aneg * softplusf_(ai + dtb);
#pragma unroll
            for (int o = 1; o < 64; o <<= 1) { const float t = __shfl_up(gc, o); if (lane >= o) gc += t; }
            gc_last = rdlane(gc, 63);
            egc = __expf(gc);
            if (wave == 0) { gcs[lane] = gc; betas[lane] = beta; egcs[lane] = egc; djs[lane] = __expf(gc_last - gc); }
        }
#pragma unroll
        for (int w = 0; w < 3; ++w) {
            const f32x2 (&cw)[4] = cwr[w];
            const unsigned (&raw)[11] = rawq[w];
            float o0[8], o1[8];
#pragma unroll
            for (int i = 0; i < 8; ++i) {
                float a0 = 0.f, a1 = 0.f;
#pragma unroll
                for (int j = 0; j < 4; ++j) { a0 += cw[j][0] * bflo(raw[i + j]); a1 += cw[j][1] * bfhi(raw[i + j]); }
                a0 = siluf_(a0); a1 = siluf_(a1);
                if (w < 2) {
                    const float ss = wave_sum(a0 * a0 + a1 * a1);
                    const float rs = rsqrtf(ss + 1e-6f) * (w == 0 ? 0.08838834764831845f : 1.0f);
                    a0 *= rs; a1 *= rs;
                }
                o0[i] = a0; o1[i] = a1;
            }
            if (w < 2) {
                const int off = (w == 0) ? Q_OFF : K_OFF;
#pragma unroll
                for (int i = 0; i < 8; ++i) *(LAS unsigned*)(lds + off + (wave * 8 + i) * 272 + lane * 4) = pk2(o0[i], o1[i]);
            }
            if (w >= 1) {
                const int off = (w == 1) ? KT_OFF : VT_OFF;
                u32x4 w0, w1;
                w0.x = pk2(o0[0], o0[1]); w0.y = pk2(o0[2], o0[3]); w0.z = pk2(o0[4], o0[5]); w0.w = pk2(o0[6], o0[7]);
                w1.x = pk2(o1[0], o1[1]); w1.y = pk2(o1[2], o1[3]); w1.z = pk2(o1[4], o1[5]); w1.w = pk2(o1[6], o1[7]);
                *(LAS u32x4*)(lds + off + (2 * lane) * 144 + wave * 16) = w0;
                *(LAS u32x4*)(lds + off + (2 * lane + 1) * 144 + wave * 16) = w1;
            }
        }
        if (n + 1 < 32) {
#pragma unroll
            for (int w = 0; w < 3; ++w) {
                const bf16_t* rbase = proj + (size_t)(t0 + 64 + wave * 8 - 3) * PJ1 + w * 1024 + h * 128;
#pragma unroll
                for (int i = 0; i < 11; ++i) rawq[w][i] = *(const unsigned*)(rbase + i * PJ1 + 2 * lane);
            }
            gbl = gb[(size_t)(t0 + 64 + lane) * 16 + h]; gai = gb[(size_t)(t0 + 64 + lane) * 16 + 8 + h];
        }
        lds_barrier();
        {
            const int trr = wave & 3;
            const int aoffb = (wave < 4) ? K_OFF : Q_OFF;
            bf16x8 af[4];
#pragma unroll
            for (int ks = 0; ks < 4; ++ks) af[ks] = ldsfrag(lds + aoffb + (trr * 16 + fr) * 272 + (ks * 32 + fq * 8) * 2);
            const f32x4 gi4 = *(const LAS f32x4*)(gcs + trr * 16 + fq * 4), bi4 = *(const LAS f32x4*)(betas + trr * 16 + fq * 4);
            float gj4[4];
#pragma unroll
            for (int tc = 0; tc < 4; ++tc) gj4[tc] = gcs[tc * 16 + fr];
            __builtin_amdgcn_sched_barrier(0);
#pragma unroll
            for (int tc = 0; tc < 4; ++tc) {
                f32x4 a = (f32x4){0.f, 0.f, 0.f, 0.f};
                bf16x8 bfr[4];
#pragma unroll
                for (int ks = 0; ks < 4; ++ks) bfr[ks] = ldsfrag(lds + K_OFF + (tc * 16 + fr) * 272 + (ks * 32 + fq * 8) * 2);
#pragma unroll
                for (int ks = 0; ks < 4; ++ks) a = MFMA16(af[ks], bfr[ks], a);
                const int j = tc * 16 + fr;
                const float gj = gj4[tc];
#pragma unroll
                for (int jj = 0; jj < 4; ++jj) {
                    const int i = trr * 16 + fq * 4 + jj;
                    const float gi = gi4[jj];
                    if (wave < 4) { Lm[i * 64 + j] = (j < i) ? bi4[jj] * a[jj] * __expf(gi - gj) : 0.f; }
                    else { *(LAS bf16_t*)(lds + ATT_OFF + i * 144 + j * 2) = (bf16_t)f2bf((j <= i) ? a[jj] * __expf(gi - gj) : 0.f); }
                }
            }
        }
        lds_barrier();
        if (wave == 0) {
            const int blk = lane >> 5, cl = lane & 31;
            LAS unsigned char* Lbytes = lds + L_OFF;
            LAS unsigned char* L21b = (LAS unsigned char*)part;
            {
                const int r = lane >> 1, hh = lane & 1;
                f32x4 x[4];
#pragma unroll
                for (int q = 0; q < 4; ++q) x[q] = *(const LAS f32x4*)(Lm + (32 + r) * 64 + hh * 16 + q * 4);
                u32x4 w0, w1;
                w0.x = pk2(x[0][0], x[0][1]); w0.y = pk2(x[0][2], x[0][3]); w0.z = pk2(x[1][0], x[1][1]); w0.w = pk2(x[1][2], x[1][3]);
                w1.x = pk2(x[2][0], x[2][1]); w1.y = pk2(x[2][2], x[2][3]); w1.z = pk2(x[3][0], x[3][1]); w1.w = pk2(x[3][2], x[3][3]);
                *(LAS u32x4*)(L21b + r * 64 + hh * 32) = w0; *(LAS u32x4*)(L21b + r * 64 + hh * 32 + 16) = w1;
            }
            const LAS float* Lblk = Lm + blk * (32 * 64 + 32);
            float Tc[32];
#pragma unroll
            for (int i = 0; i < 32; ++i) {
                float s0 = (cl == i) ? 1.0f : 0.0f, s1 = 0.f, s2 = 0.f, s3 = 0.f;
                f32x4 lr[8];
#pragma unroll
                for (int j4 = 0; j4 < (i + 3) / 4; ++j4) lr[j4] = *(const LAS f32x4*)(Lblk + i * 64 + j4 * 4);
                __builtin_amdgcn_sched_barrier(0);
#pragma unroll
                for (int j4 = 0; j4 < (i + 3) / 4; ++j4) {
                    const f32x4 l4 = lr[j4];
                    if (j4 * 4 + 0 < i) s0 -= l4[0] * Tc[j4 * 4 + 0];
                    if (j4 * 4 + 1 < i) s1 -= l4[1] * Tc[j4 * 4 + 1];
                    if (j4 * 4 + 2 < i) s2 -= l4[2] * Tc[j4 * 4 + 2];
                    if (j4 * 4 + 3 < i) s3 -= l4[3] * Tc[j4 * 4 + 3];
                }
                Tc[i] = (s0 + s1) + (s2 + s3);
            }
            const float sc1 = beta * egc, sc2 = beta;
#pragma unroll
            for (int i = 0; i < 32; ++i) {
                const int row = blk * 32 + i;
                *(LAS bf16_t*)(lds + TP_OFF + row * 144 + lane * 2) = (bf16_t)f2bf(Tc[i] * sc1);
                *(LAS bf16_t*)(lds + TPP_OFF + row * 144 + lane * 2) = (bf16_t)f2bf(Tc[i] * sc2);
            }
            if (blk == 1) {
#pragma unroll
                for (int i = 0; i < 32; ++i) { *(LAS bf16_t*)(lds + TP_OFF + i * 144 + lane * 2) = (bf16_t)0; *(LAS bf16_t*)(lds + TPP_OFF + i * 144 + lane * 2) = (bf16_t)0; }
            }
            LAS unsigned char* T11t = Lbytes, *T22n = Lbytes + 2048, *Xt = Lbytes + 4096;
            if (blk == 0) {
#pragma unroll
                for (int q = 0; q < 4; ++q) {
                    u32x4 w; w.x = pk2(Tc[q * 8 + 0], Tc[q * 8 + 1]); w.y = pk2(Tc[q * 8 + 2], Tc[q * 8 + 3]); w.z = pk2(Tc[q * 8 + 4], Tc[q * 8 + 5]); w.w = pk2(Tc[q * 8 + 6], Tc[q * 8 + 7]);
                    *(LAS u32x4*)(T11t + cl * 64 + q * 16) = w;
                }
            } else {
#pragma unroll
                for (int i = 0; i < 32; ++i) *(LAS bf16_t*)(T22n + i * 64 + cl * 2) = (bf16_t)f2bf(Tc[i]);
            }
            f32x4 xacc[2][2];
#pragma unroll
            for (int ti = 0; ti < 2; ++ti)
#pragma unroll
                for (int tj = 0; tj < 2; ++tj)
                    xacc[ti][tj] = MFMA16(ldsfrag(L21b + (ti * 16 + fr) * 64 + fq * 16), ldsfrag(T11t + (tj * 16 + fr) * 64 + fq * 16), ((f32x4){0.f, 0.f, 0.f, 0.f}));
#pragma unroll
            for (int ti = 0; ti < 2; ++ti)
#pragma unroll
                for (int tj = 0; tj < 2; ++tj) {
                    u32x2 w; w.x = pk2(xacc[ti][tj][0], xacc[ti][tj][1]); w.y = pk2(xacc[ti][tj][2], xacc[ti][tj][3]);
                    *(LAS u32x2*)(Xt + (tj * 16 + fr) * 64 + (ti * 16 + fq * 4) * 2) = w;
                }
#pragma unroll
            for (int tj = 0; tj < 2; ++tj) {
                const int col = tj * 16 + fr;
                const float c1 = -betas[col] * egcs[col], c2 = -betas[col];
#pragma unroll
                for (int ti = 0; ti < 2; ++ti) {
                    const f32x4 t = MFMA16(ldsfrag(T22n + (ti * 16 + fr) * 64 + fq * 16), ldsfrag(Xt + (tj * 16 + fr) * 64 + fq * 16), ((f32x4){0.f, 0.f, 0.f, 0.f}));
#pragma unroll
                    for (int jj = 0; jj < 4; ++jj) {
                        const int row = 32 + ti * 16 + fq * 4 + jj;
                        *(LAS bf16_t*)(lds + TP_OFF + row * 144 + col * 2) = (bf16_t)f2bf(t[jj] * c1);
                        *(LAS bf16_t*)(lds + TPP_OFF + row * 144 + col * 2) = (bf16_t)f2bf(t[jj] * c2);
                    }
                }
            }
        }
        lds_barrier();
        f32x4 uacc[4];
        {
            bf16x8 vb[2], kb[2];
#pragma unroll
            for (int ks = 0; ks < 2; ++ks) { vb[ks] = ldsfrag(lds + VT_OFF + (16 * wave + fr) * 144 + (ks * 32 + fq * 8) * 2); kb[ks] = ldsfrag(lds + KT_OFF + (16 * wave + fr) * 144 + (ks * 32 + fq * 8) * 2); }
#pragma unroll
            for (int tt = 0; tt < 4; ++tt) {
                f32x4 au = (f32x4){0.f, 0.f, 0.f, 0.f}, aw = (f32x4){0.f, 0.f, 0.f, 0.f};
#pragma unroll
                for (int ks = 0; ks < 2; ++ks) {
                    au = MFMA16(ldsfrag(lds + TPP_OFF + (tt * 16 + fr) * 144 + (ks * 32 + fq * 8) * 2), vb[ks], au);
                    aw = MFMA16(ldsfrag(lds + TP_OFF + (tt * 16 + fr) * 144 + (ks * 32 + fq * 8) * 2), kb[ks], aw);
                }
                uacc[tt] = au;
#pragma unroll
                for (int jj = 0; jj < 4; ++jj) *(LAS bf16_t*)(lds + K_OFF + (tt * 16 + fq * 4 + jj) * 272 + (16 * wave + fr) * 2) = (bf16_t)f2bf(aw[jj]);
            }
        }
        lds_barrier();
        {
            bf16x8 sb[4];
#pragma unroll
            for (int ks = 0; ks < 4; ++ks) sb[ks] = ldsfrag(lds + ST_OFF + (16 * wave + fr) * 272 + (ks * 32 + fq * 8) * 2);
#pragma unroll
            for (int tt = 0; tt < 4; ++tt) {
                f32x4 a = (f32x4){0.f, 0.f, 0.f, 0.f};
                bf16x8 wf[4];
#pragma unroll
                for (int ks = 0; ks < 4; ++ks) wf[ks] = ldsfrag(lds + K_OFF + (tt * 16 + fr) * 272 + (ks * 32 + fq * 8) * 2);
                const f32x4 d4 = *(const LAS f32x4*)(djs + tt * 16 + fq * 4);
#pragma unroll
                for (int ks = 0; ks < 4; ++ks) a = MFMA16(wf[ks], sb[ks], a);
                const f32x4 vn = uacc[tt] - a;
                u32x2 p0, p1;
                p0.x = pk2(vn[0], vn[1]); p0.y = pk2(vn[2], vn[3]);
                p1.x = pk2(vn[0] * d4[0], vn[1] * d4[1]); p1.y = pk2(vn[2] * d4[2], vn[3] * d4[3]);
                *(LAS u32x2*)(lds + VN_OFF + (16 * wave + fr) * 144 + (tt * 16 + fq * 4) * 2) = p0;
                *(LAS u32x2*)(lds + VNS_OFF + (16 * wave + fr) * 144 + (tt * 16 + fq * 4) * 2) = p1;
            }
        }
        lds_barrier();
        f32x4 oacc[4];
        unsigned zr[4][4];
        const bf16_t* zbase = proj + (size_t)t0 * PJ1 + 3072 + h * 128 + 16 * wave;
        const int zoffl = fq * 4 * PJ1 + fr;
        {
#pragma unroll
            for (int tt = 0; tt < 4; ++tt)
#pragma unroll
                for (int jj = 0; jj < 4; ++jj) zr[tt][jj] = zbase[(tt * 16 + jj) * PJ1 + zoffl];
            bf16x8 sb[4], vnb[2];
#pragma unroll
            for (int ks = 0; ks < 4; ++ks) sb[ks] = ldsfrag(lds + ST_OFF + (16 * wave + fr) * 272 + (ks * 32 + fq * 8) * 2);
#pragma unroll
            for (int ks = 0; ks < 2; ++ks) vnb[ks] = ldsfrag(lds + VN_OFF + (16 * wave + fr) * 144 + (ks * 32 + fq * 8) * 2);
#pragma unroll
            for (int tt = 0; tt < 4; ++tt) {
                f32x4 a = (f32x4){0.f, 0.f, 0.f, 0.f};
                bf16x8 qf[4], atf[2];
#pragma unroll
                for (int ks = 0; ks < 4; ++ks) qf[ks] = ldsfrag(lds + Q_OFF + (tt * 16 + fr) * 272 + (ks * 32 + fq * 8) * 2);
#pragma unroll
                for (int ks = 0; ks < 2; ++ks) atf[ks] = ldsfrag(lds + ATT_OFF + (tt * 16 + fr) * 144 + (ks * 32 + fq * 8) * 2);
                const f32x4 e4 = *(const LAS f32x4*)(egcs + tt * 16 + fq * 4);
#pragma unroll
                for (int ks = 0; ks < 4; ++ks) a = MFMA16(qf[ks], sb[ks], a);
                a = a * e4;
#pragma unroll
                for (int ks = 0; ks < 2; ++ks) a = MFMA16(atf[ks], vnb[ks], a);
                oacc[tt] = a;
#pragma unroll
                for (int jj = 0; jj < 4; ++jj) {
                    const float s = row16_sum(a[jj] * a[jj]);
                    if (fr == 0) part[wave * 64 + tt * 16 + fq * 4 + jj] = s;
                }
            }
            const float glast = __expf(gc_last);
            bf16x8 vsb[2];
#pragma unroll
            for (int ks = 0; ks < 2; ++ks) vsb[ks] = ldsfrag(lds + VNS_OFF + (16 * wave + fr) * 144 + (ks * 32 + fq * 8) * 2);
#pragma unroll
            for (int dt = 0; dt < 8; ++dt) {
                f32x4 a = Sacc[dt] * glast;
                bf16x8 kf[2];
#pragma unroll
                for (int ks = 0; ks < 2; ++ks) kf[ks] = ldsfrag(lds + KT_OFF + (dt * 16 + fr) * 144 + (ks * 32 + fq * 8) * 2);
#pragma unroll
                for (int ks = 0; ks < 2; ++ks) a = MFMA16(kf[ks], vsb[ks], a);
                Sacc[dt] = a;
            }
        }
        lds_barrier();
        {
            bf16_t* obase = proj + (size_t)t0 * PJ1 + 3072 + h * 128 + 16 * wave;
            const int ooffl = fq * 4 * PJ1 + fr;
#pragma unroll
            for (int dt = 0; dt < 8; ++dt) {
                u32x2 p; p.x = pk2(Sacc[dt][0], Sacc[dt][1]); p.y = pk2(Sacc[dt][2], Sacc[dt][3]);
                *(LAS u32x2*)(lds + ST_OFF + (16 * wave + fr) * 272 + (dt * 16 + fq * 4) * 2) = p;
            }
#pragma unroll
            for (int tt = 0; tt < 4; ++tt) {
                f32x4 pw[8];
#pragma unroll
                for (int w = 0; w < 8; ++w) pw[w] = *(const LAS f32x4*)(part + w * 64 + tt * 16 + fq * 4);
                __builtin_amdgcn_sched_barrier(0);
                const f32x4 ss = ((pw[0] + pw[1]) + (pw[2] + pw[3])) + ((pw[4] + pw[5]) + (pw[6] + pw[7]));
#pragma unroll
                for (int jj = 0; jj < 4; ++jj) {
                    const float rstd = rsqrtf(ss[jj] * (1.0f / 128.0f) + 1e-6f);
                    const float z = bf2f(zr[tt][jj]);
                    const float o = oacc[tt][jj] * rstd * ng * siluf_(z);
                    obase[(tt * 16 + jj) * PJ1 + ooffl] = (bf16_t)f2bf(o);
                }
            }
        }
    }
    __syncthreads();
}

__global__ void __launch_bounds__(NTHREADS, 2) mega(Params P) {
    extern __shared__ __attribute__((aligned(16))) unsigned char lds_raw[];
    LAS unsigned char* lds = (LAS unsigned char*)lds_raw;
    cg::grid_group grid = cg::this_grid();
    unsigned char* ws = P.ws;
    bf16_t* const XB0 = (bf16_t*)(ws + WS_XB0);
    bf16_t* const XBN = (bf16_t*)(ws + 768 * MiB);
    bf16_t* PB = (bf16_t*)(ws + WS_PB);
    bf16_t* BIGb = (bf16_t*)(ws + WS_BIG);
    bf16_t* const YC0 = (bf16_t*)(ws + WS_BIG) + (size_t)T_ * PJ0;
    bf16_t* const VB = (bf16_t*)(ws + 736 * MiB);
    float* GB = (float*)(ws + WS_GB);
    float* XF = P.out;
    const int G = gridDim.x, bid = blockIdx.x;

    for (int ph = P.ph_lo; ph < P.ph_hi; ++ph) {
        if (ph > P.ph_lo) grid.sync();
        if (ph == 0) { phase_convert(P, lds); continue; }
        const int l = (ph >= 13) ? 1 : 0, s = (ph >= 13) ? (ph - 13) : (ph - 1);
        bf16_t* xcur = XB0;
        bf16_t* xoth = XB0;
        const float* lng = P.in[8] + (size_t)l * 3 * D_;
        const float* lnb = P.in[9] + (size_t)l * 3 * D_;
        if (s == 0 || s == 7) {
            const bf16_t* up = (const bf16_t*)(ws + W_FFN + (size_t)(l * 2 + (s == 7)) * (SZ_UP + SZ_DN));
            pg8::Gemm g{(l == 1 && s == 0) ? XBN : xcur, up, T_, 5632, D_, D_}; pg8::StaticOrder S; S.init(T_, 5632, G, bid);
            EpiSwiglu E{BIGb};
            pg8::gemm_phase<EpiSwiglu>(lds, g, S, E);
        } else if (s == 1 || s == 8 || s == 5) {
            const bf16_t* A; const bf16_t* Bt; int K, lda; float scale;
            if (s == 5) { A = (l == 0) ? YC0 : (BIGb + 3072); lda = (l == 0) ? D_ : PJ1; Bt = (const bf16_t*)(ws + (l == 0 ? W_AB_OUT : W_C_OUT)); K = D_; scale = 1.0f; }
            else { A = BIGb; lda = FF_; Bt = (const bf16_t*)(ws + W_FFN + (size_t)(l * 2 + (s == 8)) * (SZ_UP + SZ_DN) + SZ_UP); K = FF_; scale = 0.5f; }
            const float* res = (l == 0 && s == 1) ? P.in[0] : XF;
            const bf16_t* resb = (s == 8 || s == 5) ? xcur : (const bf16_t*)nullptr;
            bf16_t* vout = (s == 5) ? (bf16_t*)XF : VB;
            pg8::Gemm g{A, Bt, T_, D_, K, lda}; pg8::StaticOrder S; S.init(T_, D_, G, bid);
            EpiResid<true> E{res, vout, resb, scale == 0.5f ? 1 : 0};
            pg8::gemm_phase<EpiResid<true>>(lds, g, S, E);
        } else if (s == 2 || s == 6 || s == 9) {
            const int k = (s == 2) ? 0 : (s == 6 ? 1 : 2);
            phase_ln(k == 1 ? (const bf16_t*)XF : VB, XF, xcur, lng + k * D_, lnb + k * D_, false);
            if (s == 2 && l == 1) conv_plain(P.in[1] + (size_t)T_ * 256, PB, (size_t)T_ * 256);
        } else if (s == 3) {
            const bf16_t* Bt = (const bf16_t*)(ws + (l == 0 ? W_AB_IN : W_C_IN));
            const int N = (l == 0) ? 1792 : 4352;
            pg8::Gemm g{xcur, Bt, T_, N, D_, D_}; pg8::StaticOrder S; S.init(T_, N, G, bid);
            EpiProj E{BIGb, l == 0 ? PJ0 : PJ1, l == 0 ? 7 : 16, GB};
            pg8::gemm_phase<EpiProj>(lds, g, S, E);
        } else if (s == 4) {
            if (l == 0) phase_mixer0(P, lds, BIGb, YC0);
            else for (int u = bid; u < 256; u += G) gdn_unit(P, BIGb, GB, u >> 3, u & 7, lds);
        } else if (s == 10) {
            const bf16_t* Bt = (const bf16_t*)(ws + W_PLE + (size_t)l * SZ_PLE + 2097152);
            pg8::Gemm g{PB, Bt, T_, D_, 256, 256}; pg8::StaticOrder S; S.init(T_, D_, G, bid);
            EpiResid<false> E{nullptr, BIGb, nullptr, 0};
            pg8::gemm_phase<EpiResid<false>>(lds, g, S, E);
        } else {
            const bf16_t* Bt = (const bf16_t*)(ws + W_PLE + (size_t)l * SZ_PLE);
            pg8::Gemm g{xcur, Bt, T_, D_, D_, D_}; pg8::StaticOrder S; S.init(T_, D_, G, bid);
            EpiPle E{xcur, BIGb, P.in[11] + (size_t)l * D_, XF, l == 0 ? XBN : (bf16_t*)nullptr};
            pg8::gemm_phase<EpiPle>(lds, g, S, E);
        }
    }
}

constexpr int N_PHASES = 25;
extern "C" void kernel_launch(void* const* d_in, const int* in_sizes, int n_in, void* d_out, int out_size, void* d_ws, size_t ws_size, hipStream_t stream) {
    static int ready = 0;
    if (!ready) {
        if (n_in != 29 || ws_size < WS_NEED) { fprintf(stderr, "kernel_launch: unexpected problem (n_in %d, ws %zu, need %zu)\n", n_in, ws_size, (size_t)WS_NEED); }
        if (hipFuncSetAttribute((const void*)mega, hipFuncAttributeMaxDynamicSharedMemorySize, LDS_BYTES) != hipSuccess) fprintf(stderr, "kernel_launch: hipFuncSetAttribute failed\n");
        ready = 1;
    }
    Params p{};
    for (int i = 0; i < 29; ++i) p.in[i] = (const float*)d_in[i];
    p.out = (float*)d_out; p.ws = (unsigned char*)d_ws;
#if MULTI_LAUNCH
    for (int ph = 0; ph < N_PHASES; ++ph) {
        p.ph_lo = ph; p.ph_hi = ph + 1;
        hipLaunchKernelGGL(mega, dim3(256), dim3(NTHREADS), LDS_BYTES, stream, p);
    }
#else
    p.ph_lo = 0; p.ph_hi = N_PHASES;
    void* args[] = {&p};
    hipError_t e = hipLaunchCooperativeKernel((const void*)mega, dim3(256), dim3(NTHREADS), args, LDS_BYTES, stream);
    if (e != hipSuccess) fprintf(stderr, "cooperative launch failed: %s\n", hipGetErrorString(e));
#endif
}
```

```cpp
#include <hip/hip_runtime.h>
#include <hip/hip_cooperative_groups.h>
#include <cstdio>
namespace cg = cooperative_groups;

#ifndef MULTI_LAUNCH
#define MULTI_LAUNCH 0
#endif

#define LAS __attribute__((address_space(3)))
typedef unsigned short bf16_t;
typedef short bf16x8 __attribute__((ext_vector_type(8)));
typedef float f32x4 __attribute__((ext_vector_type(4)));
typedef unsigned u32x4 __attribute__((ext_vector_type(4)));
typedef unsigned u32x2 __attribute__((ext_vector_type(2)));
typedef float f32x2 __attribute__((ext_vector_type(2)));
#define DI __device__ __forceinline__

constexpr int T_ = 65536, D_ = 1024, FF_ = 2816, SEQ_ = 2048;
constexpr int NTHREADS = 512;
constexpr int LDS_BYTES = 153600;
constexpr float DN_ALPHA = 1.41421356237f;

constexpr size_t MiB = 1ull << 20;
constexpr size_t SZ_UP = 5632ull * 1024 * 2, SZ_DN = 1024ull * 2816 * 2;
constexpr size_t W_FFN = 0;
constexpr size_t W_PLE = 4 * (SZ_UP + SZ_DN);
constexpr size_t SZ_PLE = 2097152 + 524288;
constexpr size_t W_AB_IN = W_PLE + 2 * SZ_PLE;
constexpr size_t W_AB_OUT = W_AB_IN + 1792ull * 1024 * 2;
constexpr size_t W_C_IN = W_AB_OUT + 2097152;
constexpr size_t W_C_OUT = W_C_IN + 4352ull * 1024 * 2;
constexpr size_t W_WA = W_C_OUT + 2097152;
constexpr size_t W_WX = W_WA + 65536;
constexpr size_t W_END = W_WX + 65536;
static_assert(W_END <= 96 * MiB, "weights region");
constexpr size_t WS_XB0 = 96 * MiB, WS_PB = 352 * MiB, WS_BIG = 384 * MiB;
constexpr size_t WS_GB = 88 * MiB;
constexpr size_t WS_NEED = 896 * MiB;
static_assert(W_END <= WS_GB, "gb placement");

struct Params {
    const float* in[29];
    float* out;
    unsigned char* ws;
    int ph_lo, ph_hi;
};

DI int otid() { int t = threadIdx.x; asm volatile("" : "+v"(t)); return t; }
DI unsigned f2bf(float f) { unsigned u = __float_as_uint(f); u += 0x7FFFu + ((u >> 16) & 1u); return u >> 16; }
DI unsigned pk2(float lo, float hi) { return f2bf(lo) | (f2bf(hi) << 16); }
DI float bf2f(unsigned b) { return __uint_as_float(b << 16); }
DI float bflo(unsigned w) { return __uint_as_float(w << 16); }
DI float bfhi(unsigned w) { return __uint_as_float(w & 0xffff0000u); }
DI unsigned cvt_pk_bf16(float lo, float hi) { unsigned r; asm volatile("v_cvt_pk_bf16_f32 %0, %1, %2" : "=v"(r) : "v"(lo), "v"(hi)); return r; }
DI float sigmoidf_(float x) { return __builtin_amdgcn_rcpf(1.0f + __expf(-x)); }
DI float siluf_(float x) { return x * __builtin_amdgcn_rcpf(1.0f + __expf(-x)); }
DI float log1p_fast(float e) { return e < 0.03125f ? e * (1.0f - e * (0.5f - e * (0.33333334f - 0.25f * e))) : __logf(1.0f + e); }
DI float softplusf_(float x) { return x > 20.0f ? x : log1p_fast(__expf(x)); }
DI float expm1_neg(float y) { return y > -0.03125f ? y * (1.0f + 0.5f * y * (1.0f + 0.33333334f * y * (1.0f + 0.25f * y))) : __expf(y) - 1.0f; }
DI float gelu_tanh(float x) { const float u = 0.7978845608028654f * (x + 0.044715f * x * x * x); const float e = __expf(-2.0f * fabsf(u)); const float t = (1.0f - e) / (1.0f + e); return 0.5f * x * (1.0f + (u < 0.f ? -t : t)); }
DI void lds_barrier() { asm volatile("s_waitcnt lgkmcnt(0)" ::: "memory"); __builtin_amdgcn_s_barrier(); asm volatile("" ::: "memory"); }
DI bf16x8 ldsfrag(const LAS unsigned char* p) { return *(const LAS bf16x8*)p; }
#define MFMA16(a, b, c) __builtin_amdgcn_mfma_f32_16x16x32_bf16((a), (b), (c), 0, 0, 0)

namespace pg8 {
constexpr int BM = 256, BK = 64, HALF = 128, HTB = HALF * BK * 2, STAGE_BYTES = 8 * HTB, NXCD = 8, WGM = 8;
DI int lds_byte(int r, int c) { const int st = (r >> 4) * 2 + (c >> 5), rr = r & 15, cc = c & 31, ob = rr * 64 + cc * 2; return st * 1024 + (ob ^ (((ob >> 9) & 1) << 5)); }
DI void stage_rc(int b, int& R, int& C) { const int st = b / 1024, sb = b % 1024, swz = sb ^ (((sb >> 9) & 1) << 5); R = (st >> 1) * 16 + swz / 64; C = (st & 1) * 32 + (swz % 64) / 2; }
DI int perm32(int rho) { const int n = rho >> 4, i = rho & 15; return 8 * (i >> 2) + 4 * n + (i & 3); }
struct Unit { int pm, pn; };
struct Gemm { const bf16_t* A; const bf16_t* Bt; int M, N, K, lda; };
struct StaticOrder {
    int nM, nN, nwg, G, c;
    DI void init(int M, int N, int G_, int c_) { nM = M / BM; nN = N / BM; nwg = nM * nN; G = G_; c = c_; }
    DI bool next(int i, Unit& u) const {
        const long L = (long)i * G + c; if (L >= nwg) return false;
        int wgid = (int)L; { const int q = nwg / NXCD, r = nwg % NXCD, xcd = wgid % NXCD, off = wgid / NXCD; wgid = (xcd < r ? xcd * (q + 1) : r * (q + 1) + (xcd - r) * q) + off; }
        const int nig = WGM * nN, gid = wgid / nig, fm = gid * WGM, gsz = (nM - fm) < WGM ? (nM - fm) : WGM;
        u.pm = fm + ((wgid % nig) % gsz); u.pn = (wgid % nig) / gsz; return true;
    }
};

template <class Epi, bool ALIGN_EPI = true, bool SP2 = true>
DI void gemm_phase(LAS unsigned char* lds, const Gemm g, const StaticOrder& S, const Epi& E) {
    const int tid = otid(), wid = __builtin_amdgcn_readfirstlane(tid >> 6), lane = tid & 63, wr = wid >> 2, wc = wid & 3, fr = lane & 15, fq = lane >> 4;
    const int K = g.K, nt = K / BK;
    unsigned voffA[2], voffB[2];
#pragma unroll
    for (int i = 0; i < 2; ++i) { int R, C; stage_rc(tid * 16 + i * 8192, R, C); const int Rb = Epi::PERM ? ((R & ~31) + perm32(R & 31)) : R;
        voffA[i] = (unsigned)(R * g.lda + C) * 2u; voffB[i] = (unsigned)(Rb * K + C) * 2u; }
    const size_t kstep = (size_t)(BK * 2);
    const size_t hstep = (size_t)HALF * K * 2;
    const size_t tstep = 2 * hstep;
    const size_t hstepA = (size_t)HALF * g.lda * 2, tstepA = 2 * hstepA;
    const unsigned ldsw = (unsigned)wid * 1024u;
    const int aoff = lds_byte(wr * 64 + fr, fq * 8), boff = lds_byte(wc * 32 + fr, fq * 8);
#define PG8_SA(b, h) (((b) * 2 + (h)) * HTB)
#define PG8_SB(b, h) ((4 + (b) * 2 + (h)) * HTB)
#define PG8_STAGE(bufoff, gbase, voff) do { const __attribute__((address_space(1))) char* _gb = (const __attribute__((address_space(1))) char*)(gbase); asm volatile("" : "+s"(_gb));   \
        _Pragma("unroll") for (int _i = 0; _i < 2; ++_i) { unsigned _vo = (voff)[_i]; asm volatile("" : "+v"(_vo));   \
        __builtin_amdgcn_global_load_lds((const __attribute__((address_space(1))) unsigned*)(_gb + _vo), (LAS unsigned*)(lds + (bufoff) + ldsw + _i * 8192), 16, 0, 0); } } while (0)
#define PG8_LDA(dst, b, h) do { _Pragma("unroll") for (int m = 0; m < 4; ++m) _Pragma("unroll") for (int k = 0; k < 2; ++k) dst[m][k] = *(const LAS bf16x8*)(lds + PG8_SA(b, h) + aoff + m * 2048 + k * 1024); } while (0)
#define PG8_LDB(dst, b, h) do { _Pragma("unroll") for (int n = 0; n < 2; ++n) _Pragma("unroll") for (int k = 0; k < 2; ++k) dst[n][k] = *(const LAS bf16x8*)(lds + PG8_SB(b, h) + boff + n * 2048 + k * 1024); } while (0)
#define PG8_MMA(ai, bj, At, Bt) do { __builtin_amdgcn_s_setprio(1); _Pragma("unroll") for (int m = 0; m < 4; ++m) _Pragma("unroll") for (int n = 0; n < 2; ++n) _Pragma("unroll") for (int k = 0; k < 2; ++k) \
        acc[ai][bj][m][n] = __builtin_amdgcn_mfma_f32_16x16x32_bf16(Bt[n][k], At[m][k], acc[ai][bj][m][n], 0, 0, 0); __builtin_amdgcn_s_setprio(0); } while (0)
#define PG8_WAIT_V(n) asm volatile("s_waitcnt vmcnt(" #n ")" ::: "memory")
#define PG8_WAIT_L(n) asm volatile("s_waitcnt lgkmcnt(" #n ")" ::: "memory")
#define PG8_BAR __builtin_amdgcn_s_barrier()
#define PG8_SCHED __builtin_amdgcn_sched_barrier(0)
    Unit cur, nxt; int ui = 0;
    if (!S.next(0, cur)) return;
    f32x4 acc[2][2][4][2];
#pragma unroll
    for (int a = 0; a < 2; ++a)
#pragma unroll
        for (int b = 0; b < 2; ++b)
#pragma unroll
            for (int m = 0; m < 4; ++m)
#pragma unroll
                for (int n = 0; n < 2; ++n) acc[a][b][m][n] = (f32x4){0.f, 0.f, 0.f, 0.f};
    bf16x8 At[4][2], B0[2][2], B1[2][2];
    const char* cA = (const char*)g.A + (size_t)cur.pm * tstepA; const char* cB = (const char*)g.Bt + (size_t)cur.pn * tstep;
    if constexpr (SP2) {
        PG8_STAGE(PG8_SB(0, 0), cB, voffB); PG8_STAGE(PG8_SB(0, 1), cB + hstep, voffB); PG8_STAGE(PG8_SA(0, 0), cA, voffA); PG8_STAGE(PG8_SA(0, 1), cA + hstepA, voffA);
        if (wr == 1) PG8_BAR;
        PG8_WAIT_V(2); PG8_BAR;
        PG8_STAGE(PG8_SB(1, 0), cB + kstep, voffB); PG8_STAGE(PG8_SA(1, 0), cA + kstep, voffA); PG8_STAGE(PG8_SB(1, 1), cB + hstep + kstep, voffB);
        PG8_WAIT_V(6); PG8_BAR;
    } else {
        PG8_STAGE(PG8_SB(0, 0), cB, voffB); PG8_STAGE(PG8_SA(0, 0), cA, voffA); PG8_STAGE(PG8_SB(0, 1), cB + hstep, voffB); PG8_STAGE(PG8_SA(0, 1), cA + hstepA, voffA);
        if (wr == 1) PG8_BAR;
        PG8_WAIT_V(4); PG8_BAR;
        PG8_STAGE(PG8_SB(1, 0), cB + kstep, voffB); PG8_STAGE(PG8_SA(1, 0), cA + kstep, voffA); PG8_STAGE(PG8_SB(1, 1), cB + hstep + kstep, voffB);
        PG8_WAIT_V(6); PG8_BAR;
    }
    for (;;) {
        const bool has_next = S.next(ui + 1, nxt);
        const char* nA = has_next ? (const char*)g.A + (size_t)nxt.pm * tstepA : cA; const char* nB = has_next ? (const char*)g.Bt + (size_t)nxt.pn * tstep : cB;
        for (int t = 0; t < nt; t += 2) {
            const bool last = (t == nt - 2);
            const char* a1 = cA + (size_t)(t + 1) * kstep;
            const char* a2 = last ? nA : cA + (size_t)(t + 2) * kstep; const char* b2 = last ? nB : cB + (size_t)(t + 2) * kstep;
            const char* a3 = a2 + kstep; const char* b3 = b2 + kstep;
            if constexpr (SP2) {
            PG8_LDB(B0, 0, 0); PG8_LDB(B1, 0, 1); PG8_SCHED; PG8_LDA(At, 0, 0); PG8_STAGE(PG8_SA(1, 1), a1 + hstepA, voffA);
            PG8_WAIT_V(8); PG8_WAIT_L(0); PG8_BAR; PG8_MMA(0, 0, At, B0); PG8_MMA(0, 1, At, B1); PG8_BAR; PG8_SCHED;
            PG8_LDA(At, 0, 1); PG8_STAGE(PG8_SB(0, 0), b2, voffB); PG8_STAGE(PG8_SB(0, 1), b2 + hstep, voffB); PG8_STAGE(PG8_SA(0, 0), a2, voffA);
            PG8_WAIT_V(8); PG8_WAIT_L(0); PG8_BAR; PG8_MMA(1, 0, At, B0); PG8_MMA(1, 1, At, B1); PG8_BAR; PG8_SCHED;
            PG8_LDB(B0, 1, 0); PG8_LDB(B1, 1, 1); PG8_SCHED; PG8_LDA(At, 1, 0); PG8_STAGE(PG8_SA(0, 1), a2 + hstepA, voffA);
            PG8_WAIT_V(8); PG8_WAIT_L(0); PG8_BAR; PG8_MMA(0, 0, At, B0); PG8_MMA(0, 1, At, B1); PG8_BAR; PG8_SCHED;
            PG8_LDA(At, 1, 1); PG8_STAGE(PG8_SB(1, 0), b3, voffB); PG8_STAGE(PG8_SB(1, 1), b3 + hstep, voffB); PG8_STAGE(PG8_SA(1, 0), a3, voffA);
            PG8_WAIT_V(8); PG8_WAIT_L(0); PG8_BAR; PG8_MMA(1, 0, At, B0); PG8_MMA(1, 1, At, B1); PG8_BAR; PG8_SCHED;
            } else {
            PG8_LDB(B0, 0, 0); PG8_SCHED; PG8_LDA(At, 0, 0); PG8_STAGE(PG8_SA(1, 1), a1 + hstepA, voffA);
            PG8_WAIT_L(8); PG8_BAR; PG8_WAIT_L(0); PG8_MMA(0, 0, At, B0); PG8_BAR; PG8_SCHED;
            PG8_LDB(B1, 0, 1); PG8_STAGE(PG8_SB(0, 0), b2, voffB);
            PG8_BAR; PG8_WAIT_L(0); PG8_MMA(0, 1, At, B1); PG8_BAR;
            PG8_LDA(At, 0, 1); PG8_STAGE(PG8_SA(0, 0), a2, voffA);
            PG8_BAR; PG8_WAIT_L(0); PG8_MMA(1, 0, At, B0); PG8_BAR; PG8_SCHED;
            PG8_STAGE(PG8_SB(0, 1), b2 + hstep, voffB);
            PG8_WAIT_V(6); PG8_BAR; PG8_MMA(1, 1, At, B1); PG8_BAR;
            PG8_LDB(B0, 1, 0); PG8_SCHED; PG8_LDA(At, 1, 0); PG8_STAGE(PG8_SA(0, 1), a2 + hstepA, voffA);
            PG8_WAIT_L(8); PG8_BAR; PG8_WAIT_L(0); PG8_MMA(0, 0, At, B0); PG8_BAR; PG8_SCHED;
            PG8_LDB(B1, 1, 1); PG8_STAGE(PG8_SB(1, 0), b3, voffB);
            PG8_BAR; PG8_WAIT_L(0); PG8_MMA(0, 1, At, B1); PG8_BAR;
            PG8_LDA(At, 1, 1); PG8_STAGE(PG8_SA(1, 0), a3, voffA);
            PG8_BAR; PG8_WAIT_L(0); PG8_MMA(1, 0, At, B0); PG8_BAR; PG8_SCHED;
            PG8_STAGE(PG8_SB(1, 1), b3 + hstep, voffB);
            PG8_WAIT_V(6); PG8_BAR; PG8_MMA(1, 1, At, B1); PG8_BAR;
            }
        }
        if constexpr (ALIGN_EPI) { if (wr == 0) PG8_BAR; }
        { const int t2 = otid(), l2 = t2 & 63; E(acc, cur, wr, (t2 >> 6) & 3, l2 & 15, l2 >> 4); }
        if (!has_next) break;
#pragma unroll
        for (int a = 0; a < 2; ++a)
#pragma unroll
            for (int b = 0; b < 2; ++b)
#pragma unroll
                for (int m = 0; m < 4; ++m)
#pragma unroll
                    for (int n = 0; n < 2; ++n) acc[a][b][m][n] = (f32x4){0.f, 0.f, 0.f, 0.f};
        cur = nxt; cA = nA; cB = nB; ++ui;
        if constexpr (ALIGN_EPI) { if (wr == 1) PG8_BAR; }
    }
    PG8_WAIT_V(0);
    if constexpr (!ALIGN_EPI) { if (wr == 0) PG8_BAR; }
    PG8_BAR;
#undef PG8_SA
#undef PG8_SB
#undef PG8_STAGE
#undef PG8_LDA
#undef PG8_LDB
#undef PG8_MMA
#undef PG8_WAIT_V
#undef PG8_WAIT_L
#undef PG8_BAR
#undef PG8_SCHED
}
}

struct EpiSwiglu {
    static constexpr bool PERM = true;
    bf16_t* H;
    DI void operator()(const f32x4 (&acc)[2][2][4][2], const pg8::Unit& u, int wr, int wc, int fr, int fq) const {
        const int row0 = u.pm * 256 + wr * 64 + fr, col0 = u.pn * 128 + wc * 32 + 8 * fq;
#pragma unroll
        for (int ai = 0; ai < 2; ++ai)
#pragma unroll
            for (int m = 0; m < 4; ++m) {
                bf16_t* rowp = H + (size_t)(row0 + ai * 128 + m * 16) * FF_ + col0;
                float h[8];
#pragma unroll
                for (int n = 0; n < 2; ++n)
#pragma unroll
                    for (int j = 0; j < 4; ++j) { const float gg = acc[ai][0][m][n][j], uu = acc[ai][1][m][n][j]; h[n * 4 + j] = siluf_(gg) * uu; }
                u32x4 w; w.x = cvt_pk_bf16(h[0], h[1]); w.y = cvt_pk_bf16(h[2], h[3]); w.z = cvt_pk_bf16(h[4], h[5]); w.w = cvt_pk_bf16(h[6], h[7]);
                *(u32x4*)rowp = w;
            }
    }
};
template <bool HAS_RES> struct EpiResid {
    static constexpr bool PERM = true;
    const float* res; bf16_t* out; const bf16_t* resb; int half;
    DI void operator()(const f32x4 (&acc)[2][2][4][2], const pg8::Unit& u, int wr, int wc, int fr, int fq) const {
        const int row0 = u.pm * 256 + wr * 64 + fr, col0 = u.pn * 256 + wc * 32 + 8 * fq;
        const float sc = half ? 0.5f : 1.0f;
#pragma unroll
        for (int ai = 0; ai < 2; ++ai)
#pragma unroll
            for (int m = 0; m < 4; ++m) {
                const size_t off = (size_t)(row0 + ai * 128 + m * 16) * D_ + col0;
#pragma unroll
                for (int bj = 0; bj < 2; ++bj) {
                    const size_t o = off + bj * 128;
                    f32x4 v0 = acc[ai][bj][m][0] * sc, v1 = acc[ai][bj][m][1] * sc;
                    if (HAS_RES) {
                        f32x4 r0, r1;
                        if (resb) { const u32x4 rb = *(const u32x4*)(resb + o); r0 = (f32x4){bflo(rb.x), bfhi(rb.x), bflo(rb.y), bfhi(rb.y)}; r1 = (f32x4){bflo(rb.z), bfhi(rb.z), bflo(rb.w), bfhi(rb.w)}; }
                        else { r0 = *(const f32x4*)(res + o); r1 = *(const f32x4*)(res + o + 4); }
                        v0 = v0 + r0 * DN_ALPHA; v1 = v1 + r1 * DN_ALPHA;
                    }
                    u32x4 w; w.x = cvt_pk_bf16(v0[0], v0[1]); w.y = cvt_pk_bf16(v0[2], v0[3]); w.z = cvt_pk_bf16(v1[0], v1[1]); w.w = cvt_pk_bf16(v1[2], v1[3]);
                    *(u32x4*)(out + o) = w;
                }
            }
    }
};
struct EpiProj {
    static constexpr bool PERM = true;
    bf16_t* O; int ldc; int n_main; float* gb;
    DI void operator()(const f32x4 (&acc)[2][2][4][2], const pg8::Unit& u, int wr, int wc, int fr, int fq) const {
        const int row0 = u.pm * 256 + wr * 64 + fr;
        if (u.pn < n_main) {
            const int col0 = u.pn * 256 + wc * 32 + 8 * fq;
#pragma unroll
            for (int ai = 0; ai < 2; ++ai)
#pragma unroll
                for (int m = 0; m < 4; ++m) {
                    bf16_t* rowp = O + (size_t)(row0 + ai * 128 + m * 16) * ldc + col0;
#pragma unroll
                    for (int bj = 0; bj < 2; ++bj) {
                        const f32x4 v0 = acc[ai][bj][m][0], v1 = acc[ai][bj][m][1];
                        u32x4 w; w.x = cvt_pk_bf16(v0[0], v0[1]); w.y = cvt_pk_bf16(v0[2], v0[3]); w.z = cvt_pk_bf16(v1[0], v1[1]); w.w = cvt_pk_bf16(v1[2], v1[3]);
                        *(u32x4*)(rowp + bj * 128) = w;
                    }
                }
        } else if (wc == 0 && fq < 2) {
#pragma unroll
            for (int ai = 0; ai < 2; ++ai)
#pragma unroll
                for (int m = 0; m < 4; ++m) {
                    float* rp = gb + (size_t)(row0 + ai * 128 + m * 16) * 16 + 8 * fq;
                    *(f32x4*)rp = acc[ai][0][m][0]; *(f32x4*)(rp + 4) = acc[ai][0][m][1];
                }
        }
    }
};
struct EpiPle {
    static constexpr bool PERM = true;
    const bf16_t* xb; const bf16_t* pp; const float* bg; float* out; bf16_t* xbn;
    DI void operator()(const f32x4 (&acc)[2][2][4][2], const pg8::Unit& u, int wr, int wc, int fr, int fq) const {
        const int row0 = u.pm * 256 + wr * 64 + fr, col0 = u.pn * 256 + wc * 32 + 8 * fq;
#pragma unroll
        for (int ai = 0; ai < 2; ++ai)
#pragma unroll
            for (int m = 0; m < 4; ++m) {
                const size_t off = (size_t)(row0 + ai * 128 + m * 16) * D_ + col0;
#pragma unroll
                for (int bj = 0; bj < 2; ++bj) {
                    const size_t o = off + bj * 128;
                    const f32x4 b0 = *(const f32x4*)(bg + col0 + bj * 128), b1 = *(const f32x4*)(bg + col0 + bj * 128 + 4);
                    const u32x4 rb = *(const u32x4*)(xb + o);
                    const u32x4 pb = *(const u32x4*)(pp + o);
                    const f32x4 x0 = (f32x4){bflo(rb.x), bfhi(rb.x), bflo(rb.y), bfhi(rb.y)}, x1 = (f32x4){bflo(rb.z), bfhi(rb.z), bflo(rb.w), bfhi(rb.w)};
                    const f32x4 p0 = (f32x4){bflo(pb.x), bfhi(pb.x), bflo(pb.y), bfhi(pb.y)}, p1 = (f32x4){bflo(pb.z), bfhi(pb.z), bflo(pb.w), bfhi(pb.w)};
                    f32x4 v0, v1;
#pragma unroll
                    for (int j = 0; j < 4; ++j) { v0[j] = x0[j] + sigmoidf_(acc[ai][bj][m][0][j] + b0[j]) * p0[j]; v1[j] = x1[j] + sigmoidf_(acc[ai][bj][m][1][j] + b1[j]) * p1[j]; }
                    *(f32x4*)(out + o) = v0; *(f32x4*)(out + o + 4) = v1;
                    if (xbn) { u32x4 w; w.x = cvt_pk_bf16(v0[0], v0[1]); w.y = cvt_pk_bf16(v0[2], v0[3]); w.z = cvt_pk_bf16(v1[0], v1[1]); w.w = cvt_pk_bf16(v1[2], v1[3]); *(u32x4*)(xbn + o) = w; }
                }
            }
    }
};

DI void conv_plain(const float* src, bf16_t* dst, size_t n) {
    const size_t stride = (size_t)gridDim.x * NTHREADS * 8;
    for (size_t i = ((size_t)blockIdx.x * NTHREADS + otid()) * 8; i < n; i += stride) {
        const f32x4 a = *(const f32x4*)(src + i), b = *(const f32x4*)(src + i + 4);
        u32x4 w; w.x = pk2(a[0], a[1]); w.y = pk2(a[2], a[3]); w.z = pk2(b[0], b[1]); w.w = pk2(b[2], b[3]);
        *(u32x4*)(dst + i) = w;
    }
}
DI void conv_T(const float* src, int K, int N, bf16_t* dst, int grp, int gstride, int goff, LAS float* tile) {
    const int tid = otid();
    const int ntn = (N + 63) / 64, ntk = K / 64, ntile = ntn * ntk;
    const int kk0 = tid >> 4, n4 = (tid & 15) * 4;
    f32x4 v[2];
    int t = blockIdx.x;
    if (t < ntile) {
        const int k0 = (t / ntn) * 64, n = (t % ntn) * 64 + n4;
#pragma unroll
        for (int p = 0; p < 2; ++p) v[p] = (n < N) ? *(const f32x4*)(src + (size_t)(k0 + kk0 + 32 * p) * N + n) : (f32x4){0.f, 0.f, 0.f, 0.f};
    }
    for (; t < ntile; t += gridDim.x) {
        const int k0 = (t / ntn) * 64, n0 = (t % ntn) * 64;
#pragma unroll
        for (int p = 0; p < 2; ++p) {
            const int kk = kk0 + 32 * p;
            tile[kk * 65 + n4 + 0] = v[p][0]; tile[kk * 65 + n4 + 1] = v[p][1]; tile[kk * 65 + n4 + 2] = v[p][2]; tile[kk * 65 + n4 + 3] = v[p][3];
        }
        const int tn_ = t + gridDim.x;
        if (tn_ < ntile) {
            const int k1 = (tn_ / ntn) * 64, n = (tn_ % ntn) * 64 + n4;
#pragma unroll
            for (int p = 0; p < 2; ++p) v[p] = (n < N) ? *(const f32x4*)(src + (size_t)(k1 + kk0 + 32 * p) * N + n) : (f32x4){0.f, 0.f, 0.f, 0.f};
        }
        lds_barrier();
        {
            const int nn = tid >> 3, k8 = (tid & 7) * 8, n = n0 + nn;
            if (n < N) {
                float x[8];
#pragma unroll
                for (int j = 0; j < 8; ++j) x[j] = tile[(k8 + j) * 65 + nn];
                u32x4 w; w.x = pk2(x[0], x[1]); w.y = pk2(x[2], x[3]); w.z = pk2(x[4], x[5]); w.w = pk2(x[6], x[7]);
                const size_t row = (size_t)(n / grp) * gstride + (n % grp) + goff;
                *(u32x4*)(dst + row * K + k0 + k8) = w;
            }
        }
        lds_barrier();
    }
}

DI void phase_convert(const Params& P, LAS unsigned char* lds) {
    LAS float* tile = (LAS float*)lds;
    bf16_t* W = (bf16_t*)P.ws;
    for (int l = 0; l < 2; ++l)
        for (int w = 0; w < 2; ++w) {
            bf16_t* up = (bf16_t*)(P.ws + W_FFN + (size_t)(l * 2 + w) * (SZ_UP + SZ_DN));
            bf16_t* dn = (bf16_t*)((unsigned char*)up + SZ_UP);
            const float* wg = P.in[w ? 5 : 2] + (size_t)l * D_ * FF_;
            const float* wu = P.in[w ? 6 : 3] + (size_t)l * D_ * FF_;
            const float* wd = P.in[w ? 7 : 4] + (size_t)l * FF_ * D_;
            conv_T(wg, D_, FF_, up, 128, 256, 0, tile);
            conv_T(wu, D_, FF_, up, 128, 256, 128, tile);
            conv_T(wd, FF_, D_, dn, 1 << 30, 0, 0, tile);
        }
    for (int l = 0; l < 2; ++l) {
        bf16_t* g = (bf16_t*)(P.ws + W_PLE + (size_t)l * SZ_PLE);
        bf16_t* pw = (bf16_t*)((unsigned char*)g + 2097152);
        conv_T(P.in[10] + (size_t)l * D_ * D_, D_, D_, g, 1 << 30, 0, 0, tile);
        conv_T(P.in[12] + (size_t)l * 256 * D_, 256, D_, pw, 1 << 30, 0, 0, tile);
    }
    conv_T(P.in[13], D_, 1792, (bf16_t*)(P.ws + W_AB_IN), 1 << 30, 0, 0, tile);
    conv_T(P.in[22], D_, D_, (bf16_t*)(P.ws + W_AB_OUT), 1 << 30, 0, 0, tile);
    conv_T(P.in[23], D_, 4112, (bf16_t*)(P.ws + W_C_IN), 1 << 30, 0, 0, tile);
    conv_T(P.in[28], D_, D_, (bf16_t*)(P.ws + W_C_OUT), 1 << 30, 0, 0, tile);
    for (int hb = 0; hb < 8; ++hb) {
        conv_T(P.in[17] + hb * 4096, 64, 64, (bf16_t*)(P.ws + W_WA) + hb * 4096, 1 << 30, 0, 0, tile);
        conv_T(P.in[19] + hb * 4096, 64, 64, (bf16_t*)(P.ws + W_WX) + hb * 4096, 1 << 30, 0, 0, tile);
    }
    conv_plain(P.in[0], (bf16_t*)(P.ws + WS_XB0), (size_t)T_ * D_);
    conv_plain(P.in[1], (bf16_t*)(P.ws + WS_PB), (size_t)T_ * 256);
    (void)W;
}

template <int CTRL> DI float dppf(float v) { return __builtin_bit_cast(float, __builtin_amdgcn_update_dpp(0, __builtin_bit_cast(int, v), CTRL, 0xF, 0xF, true)); }
DI float row16_sum(float v) { v += dppf<0xB1>(v); v += dppf<0x4E>(v); v += dppf<0x141>(v); v += dppf<0x140>(v); return v; }
DI float row16_max(float v) { v = fmaxf(v, dppf<0xB1>(v)); v = fmaxf(v, dppf<0x4E>(v)); v = fmaxf(v, dppf<0x141>(v)); v = fmaxf(v, dppf<0x140>(v)); return v; }
DI float rdlane(float v, int l) { return __builtin_bit_cast(float, __builtin_amdgcn_readlane(__builtin_bit_cast(int, v), l)); }
DI float wave_sum(float v) { v = row16_sum(v); return (rdlane(v, 0) + rdlane(v, 16)) + (rdlane(v, 32) + rdlane(v, 48)); }
DI void phase_ln(const bf16_t* vin, float* xf, bf16_t* xb, const float* g, const float* b, bool write_f32) {
    const int tid = otid(), wave = tid >> 6, lane = tid & 63;
    f32x4 gv[4], bv[4];
#pragma unroll
    for (int i = 0; i < 4; ++i) { gv[i] = *(const f32x4*)(g + i * 256 + lane * 4); bv[i] = *(const f32x4*)(b + i * 256 + lane * 4); }
    const int nw = gridDim.x * 8;
    constexpr int R = 4;
    for (int r0 = blockIdx.x * 8 + wave; r0 < T_; r0 += nw * R) {
        f32x4 v[R][4];
#pragma unroll
        for (int k = 0; k < R; ++k) {
            const bf16_t* row = vin + (size_t)(r0 + k * nw) * D_;
#pragma unroll
            for (int i = 0; i < 4; ++i) { const u32x2 w = *(const u32x2*)(row + i * 256 + lane * 4); v[k][i] = (f32x4){bflo(w.x), bfhi(w.x), bflo(w.y), bfhi(w.y)}; }
        }
#pragma unroll
        for (int k = 0; k < R; ++k) {
            float s = 0.f;
#pragma unroll
            for (int i = 0; i < 4; ++i) s += (v[k][i][0] + v[k][i][1]) + (v[k][i][2] + v[k][i][3]);
            const float mean = wave_sum(s) * (1.0f / 1024.0f);
            float q = 0.f;
#pragma unroll
            for (int i = 0; i < 4; ++i) { const f32x4 d = v[k][i] - mean; q += (d[0] * d[0] + d[1] * d[1]) + (d[2] * d[2] + d[3] * d[3]); }
            const float rstd = rsqrtf(wave_sum(q) * (1.0f / 1024.0f) + 1e-5f);
            float* row = xf + (size_t)(r0 + k * nw) * D_;
            bf16_t* rb = xb + (size_t)(r0 + k * nw) * D_;
#pragma unroll
            for (int i = 0; i < 4; ++i) {
                const f32x4 o = (v[k][i] - mean) * rstd * gv[i] + bv[i];
                if (write_f32) *(f32x4*)(row + i * 256 + lane * 4) = o;
                u32x2 w; w.x = pk2(o[0], o[1]); w.y = pk2(o[2], o[3]);
                *(u32x2*)(rb + i * 256 + lane * 4) = w;
            }
        }
    }
}

constexpr int PJ0 = 1792;
DI void attn_unit(const bf16_t* proj, bf16_t* ycat, const float* sinks, int b, int n, int kvh, LAS unsigned char* lds) {
    constexpr int KS_OFF = 0, VT_OFF = 27648, PS_OFF = 53248;
    const int tid = otid(), wave = tid >> 6, lane = tid & 63, fr = lane & 15, fq = lane >> 4;
    u32x4 kva[3], vva[3];
#pragma unroll
    for (int it = 0; it < 3; ++it) {
        const int idx = tid + NTHREADS * it, s = idx >> 3, d8 = idx & 7;
        const int pos = (n - 2) * 64 + s;
        kva[it] = (u32x4){0u, 0u, 0u, 0u}; vva[it] = (u32x4){0u, 0u, 0u, 0u};
        if (pos >= 0) {
            const bf16_t* rp = proj + (size_t)(b * SEQ_ + pos) * PJ0;
            kva[it] = *(const u32x4*)(rp + 512 + kvh * 64 + d8 * 8);
            vva[it] = *(const u32x4*)(rp + 640 + kvh * 64 + d8 * 8);
        }
    }
    bf16x8 qall[2][2];
    {
        const int g_ = wave >> 1, hh_ = kvh * 4 + g_, rh_ = wave & 1;
#pragma unroll
        for (int rt = 0; rt < 2; ++rt)
#pragma unroll
            for (int ks = 0; ks < 2; ++ks)
                qall[rt][ks] = *(const bf16x8*)(proj + (size_t)(b * SEQ_ + n * 64 + rh_ * 32 + rt * 16 + fr) * PJ0 + hh_ * 64 + ks * 32 + fq * 8);
    }
#pragma unroll
    for (int it = 0; it < 3; ++it) {
        const int idx = tid + NTHREADS * it, s = idx >> 3, d8 = idx & 7;
        const u32x4 kv = kva[it], vv = vva[it];
        *(LAS u32x4*)(lds + KS_OFF + s * 144 + d8 * 16) = kv;
        const unsigned vw[4] = {vv.x, vv.y, vv.z, vv.w};
#pragma unroll
        for (int j = 0; j < 4; ++j) {
            *(LAS bf16_t*)(lds + VT_OFF + (d8 * 8 + 2 * j) * 400 + s * 2) = (bf16_t)(vw[j] & 0xffffu);
            *(LAS bf16_t*)(lds + VT_OFF + (d8 * 8 + 2 * j + 1) * 400 + s * 2) = (bf16_t)(vw[j] >> 16);
        }
    }
    __syncthreads();
    const int g = wave >> 1, hh = kvh * 4 + g, rh = wave & 1;
    const float slope = exp2f(-(float)(hh + 1)), sink = sinks[hh];
    LAS unsigned char* Ps = lds + PS_OFF + wave * 6400;
    for (int rt = 0; rt < 2; ++rt) {
        const int c0 = rh * 32 + rt * 16;
        bf16x8 qa[2];
#pragma unroll
        for (int ks = 0; ks < 2; ++ks) qa[ks] = (rt == 0) ? qall[0][ks] : qall[1][ks];
        f32x4 sc[12];
#pragma unroll
        for (int kt = 0; kt < 12; ++kt) {
            f32x4 a = (f32x4){0.f, 0.f, 0.f, 0.f};
#pragma unroll
            for (int ks = 0; ks < 2; ++ks) a = MFMA16(qa[ks], ldsfrag(lds + KS_OFF + (kt * 16 + fr) * 144 + (ks * 32 + fq * 8) * 2), a);
            sc[kt] = a;
        }
        float mx[4] = {-3.0e38f, -3.0e38f, -3.0e38f, -3.0e38f};
#pragma unroll
        for (int kt = 0; kt < 12; ++kt) {
            const int s = kt * 16 + fr;
            const bool valid = ((n - 2) * 64 + s) >= 0;
#pragma unroll
            for (int j = 0; j < 4; ++j) {
                const int c = c0 + fq * 4 + j;
                const float dist = fabsf((float)(c + 128 - s));
                const float v = valid ? (sc[kt][j] * 0.125f - slope * dist) : -3.0e38f;
                sc[kt][j] = v; mx[j] = fmaxf(mx[j], v);
            }
        }
        float den[4];
#pragma unroll
        for (int j = 0; j < 4; ++j) {
            float m = mx[j];
            m = row16_max(m);
            m = fmaxf(m, sink); mx[j] = m;
            float ssum = 0.f;
#pragma unroll
            for (int kt = 0; kt < 12; ++kt) { const float p = (sc[kt][j] > -1.0e38f) ? __expf(sc[kt][j] - m) : 0.f; sc[kt][j] = p; ssum += p; }
            ssum = row16_sum(ssum);
            den[j] = 1.0f / (ssum + __expf(sink - m));
        }
#pragma unroll
        for (int kt = 0; kt < 12; ++kt)
#pragma unroll
            for (int j = 0; j < 4; ++j) *(LAS bf16_t*)(Ps + (fq * 4 + j) * 400 + (kt * 16 + fr) * 2) = (bf16_t)f2bf(sc[kt][j] * den[j]);
        __syncthreads();
#pragma unroll
        for (int dt = 0; dt < 4; ++dt) {
            f32x4 o = (f32x4){0.f, 0.f, 0.f, 0.f};
#pragma unroll
            for (int ks = 0; ks < 6; ++ks)
                o = MFMA16(ldsfrag(Ps + fr * 400 + (ks * 32 + fq * 8) * 2), ldsfrag(lds + VT_OFF + (dt * 16 + fr) * 400 + (ks * 32 + fq * 8) * 2), o);
#pragma unroll
            for (int j = 0; j < 4; ++j)
                ycat[(size_t)(b * SEQ_ + n * 64 + c0 + fq * 4 + j) * D_ + hh * 64 + dt * 16 + fr] = (bf16_t)f2bf(o[j]);
        }
        __syncthreads();
    }
}

DI void rglru_unit(const Params& P, const bf16_t* proj, bf16_t* ycat, int b, int hb, LAS unsigned char* lds) {
    constexpr int WA_OFF = 0, WX_OFF = 9216, BXC_OFF = 18432, BXF_OFF = 27648, A_OFF = 44032, U_OFF = 60416;
    const int tid = otid(), wave = tid >> 6, lane = tid & 63, fr = lane & 15, fq = lane >> 4;
    {
        const int j = tid >> 3, c8 = tid & 7;
        *(LAS u32x4*)(lds + WA_OFF + j * 144 + c8 * 16) = *(const u32x4*)((const bf16_t*)(P.ws + W_WA) + hb * 4096 + j * 64 + c8 * 8);
        *(LAS u32x4*)(lds + WX_OFF + j * 144 + c8 * 16) = *(const u32x4*)((const bf16_t*)(P.ws + W_WX) + hb * 4096 + j * 64 + c8 * 8);
    }
    const int ch = tid & 63, tg = tid >> 6;
    float cw[4];
#pragma unroll
    for (int j = 0; j < 4; ++j) cw[j] = P.in[15][j * 512 + hb * 64 + ch];
    const float cb = P.in[16][hb * 64 + ch];
    const int tr = wave >> 1, ctb = 2 * (wave & 1);
    float ba[2], bxb[2], spl[2];
#pragma unroll
    for (int c = 0; c < 2; ++c) { const int cc = hb * 64 + (ctb + c) * 16 + fr; ba[c] = P.in[18][cc]; bxb[c] = P.in[20][cc]; spl[c] = softplusf_(-P.in[21][cc]); }
    float hstate = 0.f;
    LAS float* BXF = (LAS float*)(lds + BXF_OFF); LAS float* AA = (LAS float*)(lds + A_OFF); LAS float* UU = (LAS float*)(lds + U_OFF);
    unsigned rawn[11], bgrn[8];
#pragma unroll
    for (int i = 0; i < 11; ++i) { const int sp = tg * 8 - 3 + i; rawn[i] = (sp >= 0) ? (unsigned)proj[(size_t)(b * SEQ_ + sp) * PJ0 + 768 + hb * 64 + ch] : 0u; }
#pragma unroll
    for (int i = 0; i < 8; ++i) bgrn[i] = proj[(size_t)(b * SEQ_ + tg * 8 + i) * PJ0 + 1280 + hb * 64 + ch];
#pragma unroll 1
    for (int n = 0; n < 32; ++n) {
        const int t0 = b * SEQ_ + n * 64;
        float raw[11]; unsigned bgr[8];
#pragma unroll
        for (int i = 0; i < 11; ++i) raw[i] = bf2f(rawn[i]);
#pragma unroll
        for (int i = 0; i < 8; ++i) bgr[i] = bgrn[i];
        if (n + 1 < 32) {
#pragma unroll
            for (int i = 0; i < 11; ++i) rawn[i] = proj[(size_t)(t0 + 64 + tg * 8 - 3 + i) * PJ0 + 768 + hb * 64 + ch];
#pragma unroll
            for (int i = 0; i < 8; ++i) bgrn[i] = proj[(size_t)(t0 + 64 + tg * 8 + i) * PJ0 + 1280 + hb * 64 + ch];
        }
#pragma unroll
        for (int i = 0; i < 8; ++i) {
            const float v = cb + cw[0] * raw[i] + cw[1] * raw[i + 1] + cw[2] * raw[i + 2] + cw[3] * raw[i + 3];
            const int tok = tg * 8 + i;
            BXF[tok * 64 + ch] = v;
            *(LAS bf16_t*)(lds + BXC_OFF + tok * 144 + ch * 2) = (bf16_t)f2bf(v);
        }
        lds_barrier();
        {
            bf16x8 af[2];
#pragma unroll
            for (int ks = 0; ks < 2; ++ks) af[ks] = ldsfrag(lds + BXC_OFF + (tr * 16 + fr) * 144 + (ks * 32 + fq * 8) * 2);
#pragma unroll
            for (int c = 0; c < 2; ++c) {
                const int ct = ctb + c;
                f32x4 ga = (f32x4){0.f, 0.f, 0.f, 0.f}, gx = (f32x4){0.f, 0.f, 0.f, 0.f};
#pragma unroll
                for (int ks = 0; ks < 2; ++ks) {
                    ga = MFMA16(af[ks], ldsfrag(lds + WA_OFF + (ct * 16 + fr) * 144 + (ks * 32 + fq * 8) * 2), ga);
                    gx = MFMA16(af[ks], ldsfrag(lds + WX_OFF + (ct * 16 + fr) * 144 + (ks * 32 + fq * 8) * 2), gx);
                }
#pragma unroll
                for (int j = 0; j < 4; ++j) {
                    const int tok = tr * 16 + fq * 4 + j, cc = ct * 16 + fr;
                    const float r = sigmoidf_(ga[j] + ba[c]), ig = sigmoidf_(gx[j] + bxb[c]);
                    const float la = -8.0f * r * spl[c];
                    const float a = __expf(la);
                    const float mult = sqrtf(fmaxf(-expm1_neg(2.0f * la), 0.f));
                    AA[tok * 64 + cc] = a;
                    UU[tok * 64 + cc] = mult * ig * BXF[tok * 64 + cc];
                }
            }
        }
        lds_barrier();
        if (wave == 0) {
#pragma unroll 1
            for (int t8 = 0; t8 < 64; t8 += 8) {
                float av[8], uv[8];
#pragma unroll
                for (int k = 0; k < 8; ++k) { av[k] = AA[(t8 + k) * 64 + lane]; uv[k] = UU[(t8 + k) * 64 + lane]; }
                __builtin_amdgcn_sched_barrier(0);
#pragma unroll
                for (int k = 0; k < 8; ++k) { hstate = av[k] * hstate + uv[k]; uv[k] = hstate; }
#pragma unroll
                for (int k = 0; k < 8; ++k) UU[(t8 + k) * 64 + lane] = uv[k];
            }
        }
        lds_barrier();
#pragma unroll
        for (int i = 0; i < 8; ++i) {
            const int tok = tg * 8 + i;
            const float y = UU[tok * 64 + ch] * gelu_tanh(bf2f(bgr[i]));
            ycat[(size_t)(t0 + tok) * D_ + 512 + hb * 64 + ch] = (bf16_t)f2bf(y);
        }
    }
    __syncthreads();
}

DI void phase_mixer0(const Params& P, LAS unsigned char* lds, const bf16_t* proj, bf16_t* ycat) {
    for (int u = blockIdx.x; u < 256; u += gridDim.x) rglru_unit(P, proj, ycat, u >> 3, u & 7, lds);
    for (int u = blockIdx.x; u < 2048; u += gridDim.x) { const int kvh = u & 1, n = (u >> 1) & 31, b = u >> 6; attn_unit(proj, ycat, P.in[14], b, n, kvh, lds); }
}

constexpr int PJ1 = 4096;
DI void gdn_unit(const Params& P, bf16_t* proj, const float* gb, int b, int h, LAS unsigned char* lds) {
    constexpr int Q_OFF = 0, K_OFF = 17408, KT_OFF = 34816, X_OFF = 53248, ST_OFF = 90112, ATT_OFF = 124928, L_OFF = 134144, MISC_OFF = 150528;
    constexpr int VT_OFF = X_OFF, TP_OFF = X_OFF + 18432, TPP_OFF = X_OFF + 27648, VN_OFF = X_OFF, VNS_OFF = X_OFF + 18432;
    const int tid = otid(), wave = __builtin_amdgcn_readfirstlane(tid >> 6), lane0 = tid & 63;
    LAS float* Lm = (LAS float*)(lds + L_OFF);
    LAS float* gcs = (LAS float*)(lds + MISC_OFF); LAS float* betas = gcs + 64; LAS float* egcs = gcs + 128; LAS float* djs = gcs + 192; LAS float* part = gcs + 256;
    for (int i = tid; i < 34816 / 4; i += NTHREADS) *(LAS unsigned*)(lds + ST_OFF + i * 4) = 0u;
    f32x4 Sacc[8];
#pragma unroll
    for (int i = 0; i < 8; ++i) Sacc[i] = (f32x4){0.f, 0.f, 0.f, 0.f};
    const float Aneg = -__expf(P.in[25][h]), dtb = P.in[26][h];
    const float ng = P.in[27][16 * wave + (lane0 & 15)];
    const float* cwp = P.in[24] + h * 128 + 2 * lane0;
    __syncthreads();
    f32x2 cwr[3][4];
#pragma unroll
    for (int w = 0; w < 3; ++w)
#pragma unroll
        for (int j = 0; j < 4; ++j) cwr[w][j] = *(const f32x2*)(cwp + j * 3072 + w * 1024);
    unsigned rawq[3][11]; float gbl, gai;
    {
        const int t00 = b * SEQ_;
#pragma unroll
        for (int w = 0; w < 3; ++w) {
            const bf16_t* rbase = proj + (size_t)(t00 + wave * 8 - 3) * PJ1 + w * 1024 + h * 128;
#pragma unroll
            for (int i = 0; i < 11; ++i) rawq[w][i] = (wave * 8 - 3 + i >= 0) ? *(const unsigned*)(rbase + i * PJ1 + 2 * lane0) : 0u;
        }
        gbl = gb[(size_t)(t00 + lane0) * 16 + h]; gai = gb[(size_t)(t00 + lane0) * 16 + 8 + h];
    }
#pragma unroll 1
    for (int n = 0; n < 32; ++n) {
        int lane = lane0; asm volatile("" : "+v"(lane));
        const int fr = lane & 15, fq = lane >> 4;
        const int t0 = b * SEQ_ + n * 64;
        float beta, gc, gc_last, egc;
        {
            const float bl = gbl, ai = gai;
            beta = sigmoidf_(bl);
            gc = Aneg * softplusf_(ai + dtb);
#pragma unroll
            for (int o = 1; o < 64; o <<= 1) { const float t = __shfl_up(gc, o); if (lane >= o) gc += t; }
            gc_last = rdlane(gc, 63);
            egc = __expf(gc);
            if (wave == 0) { gcs[lane] = gc; betas[lane] = beta; egcs[lane] = egc; djs[lane] = __expf(gc_last - gc); }
        }
#pragma unroll
        for (int w = 0; w < 3; ++w) {
            const f32x2 (&cw)[4] = cwr[w];
            const unsigned (&raw)[11] = rawq[w];
            float o0[8], o1[8];
#pragma unroll
            for (int i = 0; i < 8; ++i) {
                float a0 = 0.f, a1 = 0.f;
#pragma unroll
                for (int j = 0; j < 4; ++j) { a0 += cw[j][0] * bflo(raw[i + j]); a1 += cw[j][1] * bfhi(raw[i + j]); }
                a0 = siluf_(a0); a1 = siluf_(a1);
                if (w < 2) {
                    const float ss = wave_sum(a0 * a0 + a1 * a1);
                    const float rs = rsqrtf(ss + 1e-6f) * (w == 0 ? 0.08838834764831845f : 1.0f);
                    a0 *= rs; a1 *= rs;
                }
                o0[i] = a0; o1[i] = a1;
            }
            if (w < 2) {
                const int off = (w == 0) ? Q_OFF : K_OFF;
#pragma unroll
                for (int i = 0; i < 8; ++i) *(LAS unsigned*)(lds + off + (wave * 8 + i) * 272 + lane * 4) = pk2(o0[i], o1[i]);
            }
            if (w >= 1) {
                const int off = (w == 1) ? KT_OFF : VT_OFF;
                u32x4 w0, w1;
                w0.x = pk2(o0[0], o0[1]); w0.y = pk2(o0[2], o0[3]); w0.z = pk2(o0[4], o0[5]); w0.w = pk2(o0[6], o0[7]);
                w1.x = pk2(o1[0], o1[1]); w1.y = pk2(o1[2], o1[3]); w1.z = pk2(o1[4], o1[5]); w1.w = pk2(o1[6], o1[7]);
                *(LAS u32x4*)(lds + off + (2 * lane) * 144 + wave * 16) = w0;
                *(LAS u32x4*)(lds + off + (2 * lane + 1) * 144 + wave * 16) = w1;
            }
        }
        if (n + 1 < 32) {
#pragma unroll
            for (int w = 0; w < 3; ++w) {
                const bf16_t* rbase = proj + (size_t)(t0 + 64 + wave * 8 - 3) * PJ1 + w * 1024 + h * 128;
#pragma unroll
                for (int i = 0; i < 11; ++i) rawq[w][i] = *(const unsigned*)(rbase + i * PJ1 + 2 * lane);
            }
            gbl = gb[(size_t)(t0 + 64 + lane) * 16 + h]; gai = gb[(size_t)(t0 + 64 + lane) * 16 + 8 + h];
        }
        lds_barrier();
        {
            const int trr = wave & 3;
            const int aoffb = (wave < 4) ? K_OFF : Q_OFF;
            bf16x8 af[4];
#pragma unroll
            for (int ks = 0; ks < 4; ++ks) af[ks] = ldsfrag(lds + aoffb + (trr * 16 + fr) * 272 + (ks * 32 + fq * 8) * 2);
            const f32x4 gi4 = *(const LAS f32x4*)(gcs + trr * 16 + fq * 4), bi4 = *(const LAS f32x4*)(betas + trr * 16 + fq * 4);
            float gj4[4];
#pragma unroll
            for (int tc = 0; tc < 4; ++tc) gj4[tc] = gcs[tc * 16 + fr];
            __builtin_amdgcn_sched_barrier(0);
#pragma unroll
            for (int tc = 0; tc < 4; ++tc) {
                f32x4 a = (f32x4){0.f, 0.f, 0.f, 0.f};
                bf16x8 bfr[4];
#pragma unroll
                for (int ks = 0; ks < 4; ++ks) bfr[ks] = ldsfrag(lds + K_OFF + (tc * 16 + fr) * 272 + (ks * 32 + fq * 8) * 2);
#pragma unroll
                for (int ks = 0; ks < 4; ++ks) a = MFMA16(af[ks], bfr[ks], a);
                const int j = tc * 16 + fr;
                const float gj = gj4[tc];
#pragma unroll
                for (int jj = 0; jj < 4; ++jj) {
                    const int i = trr * 16 + fq * 4 + jj;
                    const float gi = gi4[jj];
                    if (wave < 4) { Lm[i * 64 + j] = (j < i) ? bi4[jj] * a[jj] * __expf(gi - gj) : 0.f; }
                    else { *(LAS bf16_t*)(lds + ATT_OFF + i * 144 + j * 2) = (bf16_t)f2bf((j <= i) ? a[jj] * __expf(gi - gj) : 0.f); }
                }
            }
        }
        lds_barrier();
        if (wave == 0) {
            const int blk = lane >> 5, cl = lane & 31;
            LAS unsigned char* Lbytes = lds + L_OFF;
            LAS unsigned char* L21b = (LAS unsigned char*)part;
            {
                const int r = lane >> 1, hh = lane & 1;
                f32x4 x[4];
#pragma unroll
                for (int q = 0; q < 4; ++q) x[q] = *(const LAS f32x4*)(Lm + (32 + r) * 64 + hh * 16 + q * 4);
                u32x4 w0, w1;
                w0.x = pk2(x[0][0], x[0][1]); w0.y = pk2(x[0][2], x[0][3]); w0.z = pk2(x[1][0], x[1][1]); w0.w = pk2(x[1][2], x[1][3]);
                w1.x = pk2(x[2][0], x[2][1]); w1.y = pk2(x[2][2], x[2][3]); w1.z = pk2(x[3][0], x[3][1]); w1.w = pk2(x[3][2], x[3][3]);
                *(LAS u32x4*)(L21b + r * 64 + hh * 32) = w0; *(LAS u32x4*)(L21b + r * 64 + hh * 32 + 16) = w1;
            }
            const LAS float* Lblk = Lm + blk * (32 * 64 + 32);
            float Tc[32];
#pragma unroll
            for (int i = 0; i < 32; ++i) {
                float s0 = (cl == i) ? 1.0f : 0.0f, s1 = 0.f, s2 = 0.f, s3 = 0.f;
                f32x4 lr[8];
#pragma unroll
                for (int j4 = 0; j4 < (i + 3) / 4; ++j4) lr[j4] = *(const LAS f32x4*)(Lblk + i * 64 + j4 * 4);
                __builtin_amdgcn_sched_barrier(0);
#pragma unroll
                for (int j4 = 0; j4 < (i + 3) / 4; ++j4) {
                    const f32x4 l4 = lr[j4];
                    if (j4 * 4 + 0 < i) s0 -= l4[0] * Tc[j4 * 4 + 0];
                    if (j4 * 4 + 1 < i) s1 -= l4[1] * Tc[j4 * 4 + 1];
                    if (j4 * 4 + 2 < i) s2 -= l4[2] * Tc[j4 * 4 + 2];
                    if (j4 * 4 + 3 < i) s3 -= l4[3] * Tc[j4 * 4 + 3];
                }
                Tc[i] = (s0 + s1) + (s2 + s3);
            }
            const float sc1 = beta * egc, sc2 = beta;
#pragma unroll
            for (int i = 0; i < 32; ++i) {
                const int row = blk * 32 + i;
                *(LAS bf16_t*)(lds + TP_OFF + row * 144 + lane * 2) = (bf16_t)f2bf(Tc[i] * sc1);
                *(LAS bf16_t*)(lds + TPP_OFF + row * 144 + lane * 2) = (bf16_t)f2bf(Tc[i] * sc2);
            }
            if (blk == 1) {
#pragma unroll
                for (int i = 0; i < 32; ++i) { *(LAS bf16_t*)(lds + TP_OFF + i * 144 + lane * 2) = (bf16_t)0; *(LAS bf16_t*)(lds + TPP_OFF + i * 144 + lane * 2) = (bf16_t)0; }
            }
            LAS unsigned char* T11t = Lbytes, *T22n = Lbytes + 2048, *Xt = Lbytes + 4096;
            if (blk == 0) {
#pragma unroll
                for (int q = 0; q < 4; ++q) {
                    u32x4 w; w.x = pk2(Tc[q * 8 + 0], Tc[q * 8 + 1]); w.y = pk2(Tc[q * 8 + 2], Tc[q * 8 + 3]); w.z = pk2(Tc[q * 8 + 4], Tc[q * 8 + 5]); w.w = pk2(Tc[q * 8 + 6], Tc[q * 8 + 7]);
                    *(LAS u32x4*)(T11t + cl * 64 + q * 16) = w;
                }
            } else {
#pragma unroll
                for (int i = 0; i < 32; ++i) *(LAS bf16_t*)(T22n + i * 64 + cl * 2) = (bf16_t)f2bf(Tc[i]);
            }
            f32x4 xacc[2][2];
#pragma unroll
            for (int ti = 0; ti < 2; ++ti)
#pragma unroll
                for (int tj = 0; tj < 2; ++tj)
                    xacc[ti][tj] = MFMA16(ldsfrag(L21b + (ti * 16 + fr) * 64 + fq * 16), ldsfrag(T11t + (tj * 16 + fr) * 64 + fq * 16), ((f32x4){0.f, 0.f, 0.f, 0.f}));
#pragma unroll
            for (int ti = 0; ti < 2; ++ti)
#pragma unroll
                for (int tj = 0; tj < 2; ++tj) {
                    u32x2 w; w.x = pk2(xacc[ti][tj][0], xacc[ti][tj][1]); w.y = pk2(xacc[ti][tj][2], xacc[ti][tj][3]);
                    *(LAS u32x2*)(Xt + (tj * 16 + fr) * 64 + (ti * 16 + fq * 4) * 2) = w;
                }
#pragma unroll
            for (int tj = 0; tj < 2; ++tj) {
                const int col = tj * 16 + fr;
                const float c1 = -betas[col] * egcs[col], c2 = -betas[col];
#pragma unroll
                for (int ti = 0; ti < 2; ++ti) {
                    const f32x4 t = MFMA16(ldsfrag(T22n + (ti * 16 + fr) * 64 + fq * 16), ldsfrag(Xt + (tj * 16 + fr) * 64 + fq * 16), ((f32x4){0.f, 0.f, 0.f, 0.f}));
#pragma unroll
                    for (int jj = 0; jj < 4; ++jj) {
                        const int row = 32 + ti * 16 + fq * 4 + jj;
                        *(LAS bf16_t*)(lds + TP_OFF + row * 144 + col * 2) = (bf16_t)f2bf(t[jj] * c1);
                        *(LAS bf16_t*)(lds + TPP_OFF + row * 144 + col * 2) = (bf16_t)f2bf(t[jj] * c2);
                    }
                }
            }
        }
        lds_barrier();
        f32x4 uacc[4];
        {
            bf16x8 vb[2], kb[2];
#pragma unroll
            for (int ks = 0; ks < 2; ++ks) { vb[ks] = ldsfrag(lds + VT_OFF + (16 * wave + fr) * 144 + (ks * 32 + fq * 8) * 2); kb[ks] = ldsfrag(lds + KT_OFF + (16 * wave + fr) * 144 + (ks * 32 + fq * 8) * 2); }
#pragma unroll
            for (int tt = 0; tt < 4; ++tt) {
                f32x4 au = (f32x4){0.f, 0.f, 0.f, 0.f}, aw = (f32x4){0.f, 0.f, 0.f, 0.f};
#pragma unroll
                for (int ks = 0; ks < 2; ++ks) {
                    au = MFMA16(ldsfrag(lds + TPP_OFF + (tt * 16 + fr) * 144 + (ks * 32 + fq * 8) * 2), vb[ks], au);
                    aw = MFMA16(ldsfrag(lds + TP_OFF + (tt * 16 + fr) * 144 + (ks * 32 + fq * 8) * 2), kb[ks], aw);
                }
                uacc[tt] = au;
#pragma unroll
                for (int jj = 0; jj < 4; ++jj) *(LAS bf16_t*)(lds + K_OFF + (tt * 16 + fq * 4 + jj) * 272 + (16 * wave + fr) * 2) = (bf16_t)f2bf(aw[jj]);
            }
        }
        lds_barrier();
        {
            bf16x8 sb[4];
#pragma unroll
            for (int ks = 0; ks < 4; ++ks) sb[ks] = ldsfrag(lds + ST_OFF + (16 * wave + fr) * 272 + (ks * 32 + fq * 8) * 2);
#pragma unroll
            for (int tt = 0; tt < 4; ++tt) {
                f32x4 a = (f32x4){0.f, 0.f, 0.f, 0.f};
                bf16x8 wf[4];
#pragma unroll
                for (int ks = 0; ks < 4; ++ks) wf[ks] = ldsfrag(lds + K_OFF + (tt * 16 + fr) * 272 + (ks * 32 + fq * 8) * 2);
                const f32x4 d4 = *(const LAS f32x4*)(djs + tt * 16 + fq * 4);
#pragma unroll
                for (int ks = 0; ks < 4; ++ks) a = MFMA16(wf[ks], sb[ks], a);
                const f32x4 vn = uacc[tt] - a;
                u32x2 p0, p1;
                p0.x = pk2(vn[0], vn[1]); p0.y = pk2(vn[2], vn[3]);
                p1.x = pk2(vn[0] * d4[0], vn[1] * d4[1]); p1.y = pk2(vn[2] * d4[2], vn[3] * d4[3]);
                *(LAS u32x2*)(lds + VN_OFF + (16 * wave + fr) * 144 + (tt * 16 + fq * 4) * 2) = p0;
                *(LAS u32x2*)(lds + VNS_OFF + (16 * wave + fr) * 144 + (tt * 16 + fq * 4) * 2) = p1;
            }
        }
        lds_barrier();
        f32x4 oacc[4];
        unsigned zr[4][4];
        const bf16_t* zbase = proj + (size_t)t0 * PJ1 + 3072 + h * 128 + 16 * wave;
        const int zoffl = fq * 4 * PJ1 + fr;
        {
#pragma unroll
            for (int tt = 0; tt < 4; ++tt)
#pragma unroll
                for (int jj = 0; jj < 4; ++jj) zr[tt][jj] = zbase[(tt * 16 + jj) * PJ1 + zoffl];
            bf16x8 sb[4], vnb[2];
#pragma unroll
            for (int ks = 0; ks < 4; ++ks) sb[ks] = ldsfrag(lds + ST_OFF + (16 * wave + fr) * 272 + (ks * 32 + fq * 8) * 2);
#pragma unroll
            for (int ks = 0; ks < 2; ++ks) vnb[ks] = ldsfrag(lds + VN_OFF + (16 * wave + fr) * 144 + (ks * 32 + fq * 8) * 2);
#pragma unroll
            for (int tt = 0; tt < 4; ++tt) {
                f32x4 a = (f32x4){0.f, 0.f, 0.f, 0.f};
                bf16x8 qf[4], atf[2];
#pragma unroll
                for (int ks = 0; ks < 4; ++ks) qf[ks] = ldsfrag(lds + Q_OFF + (tt * 16 + fr) * 272 + (ks * 32 + fq * 8) * 2);
#pragma unroll
                for (int ks = 0; ks < 2; ++ks) atf[ks] = ldsfrag(lds + ATT_OFF + (tt * 16 + fr) * 144 + (ks * 32 + fq * 8) * 2);
                const f32x4 e4 = *(const LAS f32x4*)(egcs + tt * 16 + fq * 4);
#pragma unroll
                for (int ks = 0; ks < 4; ++ks) a = MFMA16(qf[ks], sb[ks], a);
                a = a * e4;
#pragma unroll
                for (int ks = 0; ks < 2; ++ks) a = MFMA16(atf[ks], vnb[ks], a);
                oacc[tt] = a;
#pragma unroll
                for (int jj = 0; jj < 4; ++jj) {
                    const float s = row16_sum(a[jj] * a[jj]);
                    if (fr == 0) part[wave * 64 + tt * 16 + fq * 4 + jj] = s;
                }
            }
            const float glast = __expf(gc_last);
            bf16x8 vsb[2];
#pragma unroll
            for (int ks = 0; ks < 2; ++ks) vsb[ks] = ldsfrag(lds + VNS_OFF + (16 * wave + fr) * 144 + (ks * 32 + fq * 8) * 2);
#pragma unroll
            for (int dt = 0; dt < 8; ++dt) {
                f32x4 a = Sacc[dt] * glast;
                bf16x8 kf[2];
#pragma unroll
                for (int ks = 0; ks < 2; ++ks) kf[ks] = ldsfrag(lds + KT_OFF + (dt * 16 + fr) * 144 + (ks * 32 + fq * 8) * 2);
#pragma unroll
                for (int ks = 0; ks < 2; ++ks) a = MFMA16(kf[ks], vsb[ks], a);
                Sacc[dt] = a;
            }
        }
        lds_barrier();
        {
            bf16_t* obase = proj + (size_t)t0 * PJ1 + 3072 + h * 128 + 16 * wave;
            const int ooffl = fq * 4 * PJ1 + fr;
#pragma unroll
            for (int dt = 0; dt < 8; ++dt) {
                u32x2 p; p.x = pk2(Sacc[dt][0], Sacc[dt][1]); p.y = pk2(Sacc[dt][2], Sacc[dt][3]);
                *(LAS u32x2*)(lds + ST_OFF + (16 * wave + fr) * 272 + (dt * 16 + fq * 4) * 2) = p;
            }
#pragma unroll
            for (int tt = 0; tt < 4; ++tt) {
                f32x4 pw[8];
#pragma unroll
                for (int w = 0; w < 8; ++w) pw[w] = *(const LAS f32x4*)(part + w * 64 + tt * 16 + fq * 4);
                __builtin_amdgcn_sched_barrier(0);
                const f32x4 ss = ((pw[0] + pw[1]) + (pw[2] + pw[3])) + ((pw[4] + pw[5]) + (pw[6] + pw[7]));
#pragma unroll
                for (int jj = 0; jj < 4; ++jj) {
                    const float rstd = rsqrtf(ss[jj] * (1.0f / 128.0f) + 1e-6f);
                    const float z = bf2f(zr[tt][jj]);
                    const float o = oacc[tt][jj] * rstd * ng * siluf_(z);
                    obase[(tt * 16 + jj) * PJ1 + ooffl] = (bf16_t)f2bf(o);
                }
            }
        }
    }
    __syncthreads();
}

__global__ void __launch_bounds__(NTHREADS, 2) mega(Params P) {
    extern __shared__ __attribute__((aligned(16))) unsigned char lds_raw[];
    LAS unsigned char* lds = (LAS unsigned char*)lds_raw;
    cg::grid_group grid = cg::this_grid();
    unsigned char* ws = P.ws;
    bf16_t* const XB0 = (bf16_t*)(ws + WS_XB0);
    bf16_t* const XBN = (bf16_t*)(ws + 768 * MiB);
    bf16_t* PB = (bf16_t*)(ws + WS_PB);
    bf16_t* BIGb = (bf16_t*)(ws + WS_BIG);
    bf16_t* const YC0 = (bf16_t*)(ws + WS_BIG) + (size_t)T_ * PJ0;
    bf16_t* const VB = (bf16_t*)(ws + 736 * MiB);
    float* GB = (float*)(ws + WS_GB);
    float* XF = P.out;
    const int G = gridDim.x, bid = blockIdx.x;

    for (int ph = P.ph_lo; ph < P.ph_hi; ++ph) {
        if (ph > P.ph_lo) grid.sync();
        if (ph == 0) { phase_convert(P, lds); continue; }
        const int l = (ph >= 13) ? 1 : 0, s = (ph >= 13) ? (ph - 13) : (ph - 1);
        bf16_t* xcur = XB0;
        bf16_t* xoth = XB0;
        const float* lng = P.in[8] + (size_t)l * 3 * D_;
        const float* lnb = P.in[9] + (size_t)l * 3 * D_;
        if (s == 0 || s == 7) {
            const bf16_t* up = (const bf16_t*)(ws + W_FFN + (size_t)(l * 2 + (s == 7)) * (SZ_UP + SZ_DN));
            pg8::Gemm g{(l == 1 && s == 0) ? XBN : xcur, up, T_, 5632, D_, D_}; pg8::StaticOrder S; S.init(T_, 5632, G, bid);
            EpiSwiglu E{BIGb};
            pg8::gemm_phase<EpiSwiglu>(lds, g, S, E);
        } else if (s == 1 || s == 8 || s == 5) {
            const bf16_t* A; const bf16_t* Bt; int K, lda; float scale;
            if (s == 5) { A = (l == 0) ? YC0 : (BIGb + 3072); lda = (l == 0) ? D_ : PJ1; Bt = (const bf16_t*)(ws + (l == 0 ? W_AB_OUT : W_C_OUT)); K = D_; scale = 1.0f; }
            else { A = BIGb; lda = FF_; Bt = (const bf16_t*)(ws + W_FFN + (size_t)(l * 2 + (s == 8)) * (SZ_UP + SZ_DN) + SZ_UP); K = FF_; scale = 0.5f; }
            const float* res = (l == 0 && s == 1) ? P.in[0] : XF;
            const bf16_t* resb = (s == 8 || s == 5) ? xcur : (const bf16_t*)nullptr;
            bf16_t* vout = (s == 5) ? (bf16_t*)XF : VB;
            pg8::Gemm g{A, Bt, T_, D_, K, lda}; pg8::StaticOrder S; S.init(T_, D_, G, bid);
            EpiResid<true> E{res, vout, resb, scale == 0.5f ? 1 : 0};
            pg8::gemm_phase<EpiResid<true>>(lds, g, S, E);
        } else if (s == 2 || s == 6 || s == 9) {
            const int k = (s == 2) ? 0 : (s == 6 ? 1 : 2);
            phase_ln(k == 1 ? (const bf16_t*)XF : VB, XF, xcur, lng + k * D_, lnb + k * D_, false);
            if (s == 2 && l == 1) conv_plain(P.in[1] + (size_t)T_ * 256, PB, (size_t)T_ * 256);
        } else if (s == 3) {
            const bf16_t* Bt = (const bf16_t*)(ws + (l == 0 ? W_AB_IN : W_C_IN));
            const int N = (l == 0) ? 1792 : 4352;
            pg8::Gemm g{xcur, Bt, T_, N, D_, D_}; pg8::StaticOrder S; S.init(T_, N, G, bid);
            EpiProj E{BIGb, l == 0 ? PJ0 : PJ1, l == 0 ? 7 : 16, GB};
            pg8::gemm_phase<EpiProj>(lds, g, S, E);
        } else if (s == 4) {
            if (l == 0) phase_mixer0(P, lds, BIGb, YC0);
            else for (int u = bid; u < 256; u += G) gdn_unit(P, BIGb, GB, u >> 3, u & 7, lds);
        } else if (s == 10) {
            const bf16_t* Bt = (const bf16_t*)(ws + W_PLE + (size_t)l * SZ_PLE + 2097152);
            pg8::Gemm g{PB, Bt, T_, D_, 256, 256}; pg8::StaticOrder S; S.init(T_, D_, G, bid);
            EpiResid<false> E{nullptr, BIGb, nullptr, 0};
            pg8::gemm_phase<EpiResid<false>>(lds, g, S, E);
        } else {
            const bf16_t* Bt = (const bf16_t*)(ws + W_PLE + (size_t)l * SZ_PLE);
            pg8::Gemm g{xcur, Bt, T_, D_, D_, D_}; pg8::StaticOrder S; S.init(T_, D_, G, bid);
            EpiPle E{xcur, BIGb, P.in[11] + (size_t)l * D_, XF, l == 0 ? XBN : (bf16_t*)nullptr};
            pg8::gemm_phase<EpiPle>(lds, g, S, E);
        }
    }
}

constexpr int N_PHASES = 25;
extern "C" void kernel_launch(void* const* d_in, const int* in_sizes, int n_in, void* d_out, int out_size, void* d_ws, size_t ws_size, hipStream_t stream) {
    static int ready = 0;
    if (!ready) {
        if (n_in != 29 || ws_size < WS_NEED) { fprintf(stderr, "kernel_launch: unexpected problem (n_in %d, ws %zu, need %zu)\n", n_in, ws_size, (size_t)WS_NEED); }
        if (hipFuncSetAttribute((const void*)mega, hipFuncAttributeMaxDynamicSharedMemorySize, LDS_BYTES) != hipSuccess) fprintf(stderr, "kernel_launch: hipFuncSetAttribute failed\n");
        ready = 1;
    }
    Params p{};
    for (int i = 0; i < 29; ++i) p.in[i] = (const float*)d_in[i];
    p.out = (float*)d_out; p.ws = (unsigned char*)d_ws;
#if MULTI_LAUNCH
    for (int ph = 0; ph < N_PHASES; ++ph) {
        p.ph_lo = ph; p.ph_hi = ph + 1;
        hipLaunchKernelGGL(mega, dim3(256), dim3(NTHREADS), LDS_BYTES, stream, p);
    }
#else
    p.ph_lo = 0; p.ph_hi = N_PHASES;
    void* args[] = {&p};
    hipError_t e = hipLaunchCooperativeKernel((const void*)mega, dim3(256), dim3(NTHREADS), args, LDS_BYTES, stream);
    if (e != hipSuccess) fprintf(stderr, "cooperative launch failed: %s\n", hipGetErrorString(e));
#endif
}
```

```cpp
#include <hip/hip_runtime.h>
#include <hip/hip_cooperative_groups.h>
#include <cstdio>
namespace cg = cooperative_groups;

#ifndef MULTI_LAUNCH
#define MULTI_LAUNCH 0
#endif

#define LAS __attribute__((address_space(3)))
typedef unsigned short bf16_t;
typedef short bf16x8 __attribute__((ext_vector_type(8)));
typedef float f32x4 __attribute__((ext_vector_type(4)));
typedef unsigned u32x4 __attribute__((ext_vector_type(4)));
typedef unsigned u32x2 __attribute__((ext_vector_type(2)));
typedef float f32x2 __attribute__((ext_vector_type(2)));
#define DI __device__ __forceinline__

constexpr int T_ = 65536, D_ = 1024, FF_ = 2816, SEQ_ = 2048;
constexpr int NTHREADS = 512;
constexpr int LDS_BYTES = 153600;
constexpr float DN_ALPHA = 1.41421356237f;

constexpr size_t MiB = 1ull << 20;
constexpr size_t SZ_UP = 5632ull * 1024 * 2, SZ_DN = 1024ull * 2816 * 2;
constexpr size_t W_FFN = 0;
constexpr size_t W_PLE = 4 * (SZ_UP + SZ_DN);
constexpr size_t SZ_PLE = 2097152 + 524288;
constexpr size_t W_AB_IN = W_PLE + 2 * SZ_PLE;
constexpr size_t W_AB_OUT = W_AB_IN + 1792ull * 1024 * 2;
constexpr size_t W_C_IN = W_AB_OUT + 2097152;
constexpr size_t W_C_OUT = W_C_IN + 4352ull * 1024 * 2;
constexpr size_t W_WA = W_C_OUT + 2097152;
constexpr size_t W_WX = W_WA + 65536;
constexpr size_t W_END = W_WX + 65536;
static_assert(W_END <= 96 * MiB, "weights region");
constexpr size_t WS_XB0 = 96 * MiB, WS_PB = 352 * MiB, WS_BIG = 384 * MiB;
constexpr size_t WS_GB = 88 * MiB;
constexpr size_t WS_NEED = 896 * MiB;
static_assert(W_END <= WS_GB, "gb placement");

struct Params {
    const float* in[29];
    float* out;
    unsigned char* ws;
    int ph_lo, ph_hi;
};

DI int otid() { int t = threadIdx.x; asm volatile("" : "+v"(t)); return t; }
DI unsigned f2bf(float f) { unsigned u = __float_as_uint(f); u += 0x7FFFu + ((u >> 16) & 1u); return u >> 16; }
DI unsigned pk2(float lo, float hi) { return f2bf(lo) | (f2bf(hi) << 16); }
DI float bf2f(unsigned b) { return __uint_as_float(b << 16); }
DI float bflo(unsigned w) { return __uint_as_float(w << 16); }
DI float bfhi(unsigned w) { return __uint_as_float(w & 0xffff0000u); }
DI unsigned cvt_pk_bf16(float lo, float hi) { unsigned r; asm volatile("v_cvt_pk_bf16_f32 %0, %1, %2" : "=v"(r) : "v"(lo), "v"(hi)); return r; }
DI float sigmoidf_(float x) { return __builtin_amdgcn_rcpf(1.0f + __expf(-x)); }
DI float siluf_(float x) { return x * __builtin_amdgcn_rcpf(1.0f + __expf(-x)); }
DI float log1p_fast(float e) { return e < 0.03125f ? e * (1.0f - e * (0.5f - e * (0.33333334f - 0.25f * e))) : __logf(1.0f + e); }
DI float softplusf_(float x) { return x > 20.0f ? x : log1p_fast(__expf(x)); }
DI float expm1_neg(float y) { return y > -0.03125f ? y * (1.0f + 0.5f * y * (1.0f + 0.33333334f * y * (1.0f + 0.25f * y))) : __expf(y) - 1.0f; }
DI float gelu_tanh(float x) { const float u = 0.7978845608028654f * (x + 0.044715f * x * x * x); const float e = __expf(-2.0f * fabsf(u)); const float t = (1.0f - e) / (1.0f + e); return 0.5f * x * (1.0f + (u < 0.f ? -t : t)); }
DI void lds_barrier() { asm volatile("s_waitcnt lgkmcnt(0)" ::: "memory"); __builtin_amdgcn_s_barrier(); asm volatile("" ::: "memory"); }
DI bf16x8 ldsfrag(const LAS unsigned char* p) { return *(const LAS bf16x8*)p; }
#define MFMA16(a, b, c) __builtin_amdgcn_mfma_f32_16x16x32_bf16((a), (b), (c), 0, 0, 0)

namespace pg8 {
constexpr int BM = 256, BK = 64, HALF = 128, HTB = HALF * BK * 2, STAGE_BYTES = 8 * HTB, NXCD = 8, WGM = 8;
DI int lds_byte(int r, int c) { const int st = (r >> 4) * 2 + (c >> 5), rr = r & 15, cc = c & 31, ob = rr * 64 + cc * 2; return st * 1024 + (ob ^ (((ob >> 9) & 1) << 5)); }
DI void stage_rc(int b, int& R, int& C) { const int st = b / 1024, sb = b % 1024, swz = sb ^ (((sb >> 9) & 1) << 5); R = (st >> 1) * 16 + swz / 64; C = (st & 1) * 32 + (swz % 64) / 2; }
DI int perm32(int rho) { const int n = rho >> 4, i = rho & 15; return 8 * (i >> 2) + 4 * n + (i & 3); }
struct Unit { int pm, pn; };
struct Gemm { const bf16_t* A; const bf16_t* Bt; int M, N, K, lda; };
struct StaticOrder {
    int nM, nN, nwg, G, c;
    DI void init(int M, int N, int G_, int c_) { nM = M / BM; nN = N / BM; nwg = nM * nN; G = G_; c = c_; }
    DI bool next(int i, Unit& u) const {
        const long L = (long)i * G + c; if (L >= nwg) return false;
        int wgid = (int)L; { const int q = nwg / NXCD, r = nwg % NXCD, xcd = wgid % NXCD, off = wgid / NXCD; wgid = (xcd < r ? xcd * (q + 1) : r * (q + 1) + (xcd - r) * q) + off; }
        const int nig = WGM * nN, gid = wgid / nig, fm = gid * WGM, gsz = (nM - fm) < WGM ? (nM - fm) : WGM;
        u.pm = fm + ((wgid % nig) % gsz); u.pn = (wgid % nig) / gsz; return true;
    }
};

template <class Epi, bool ALIGN_EPI = true, bool SP2 = true>
DI void gemm_phase(LAS unsigned char* lds, const Gemm g, const StaticOrder& S, const Epi& E) {
    const int tid = otid(), wid = __builtin_amdgcn_readfirstlane(tid >> 6), lane = tid & 63, wr = wid >> 2, wc = wid & 3, fr = lane & 15, fq = lane >> 4;
    const int K = g.K, nt = K / BK;
    unsigned voffA[2], voffB[2];
#pragma unroll
    for (int i = 0; i < 2; ++i) { int R, C; stage_rc(tid * 16 + i * 8192, R, C); const int Rb = Epi::PERM ? ((R & ~31) + perm32(R & 31)) : R;
        voffA[i] = (unsigned)(R * g.lda + C) * 2u; voffB[i] = (unsigned)(Rb * K + C) * 2u; }
    const size_t kstep = (size_t)(BK * 2);
    const size_t hstep = (size_t)HALF * K * 2;
    const size_t tstep = 2 * hstep;
    const size_t hstepA = (size_t)HALF * g.lda * 2, tstepA = 2 * hstepA;
    const unsigned ldsw = (unsigned)wid * 1024u;
    const int aoff = lds_byte(wr * 64 + fr, fq * 8), boff = lds_byte(wc * 32 + fr, fq * 8);
#define PG8_SA(b, h) (((b) * 2 + (h)) * HTB)
#define PG8_SB(b, h) ((4 + (b) * 2 + (h)) * HTB)
#define PG8_STAGE(bufoff, gbase, voff) do { const __attribute__((address_space(1))) char* _gb = (const __attribute__((address_space(1))) char*)(gbase); asm volatile("" : "+s"(_gb));   \
        _Pragma("unroll") for (int _i = 0; _i < 2; ++_i) { unsigned _vo = (voff)[_i]; asm volatile("" : "+v"(_vo));   \
        __builtin_amdgcn_global_load_lds((const __attribute__((address_space(1))) unsigned*)(_gb + _vo), (LAS unsigned*)(lds + (bufoff) + ldsw + _i * 8192), 16, 0, 0); } } while (0)
#define PG8_LDA(dst, b, h) do { _Pragma("unroll") for (int m = 0; m < 4; ++m) _Pragma("unroll") for (int k = 0; k < 2; ++k) dst[m][k] = *(const LAS bf16x8*)(lds + PG8_SA(b, h) + aoff + m * 2048 + k * 1024); } while (0)
#define PG8_LDB(dst, b, h) do { _Pragma("unroll") for (int n = 0; n < 2; ++n) _Pragma("unroll") for (int k = 0; k < 2; ++k) dst[n][k] = *(const LAS bf16x8*)(lds + PG8_SB(b, h) + boff + n * 2048 + k * 1024); } while (0)
#define PG8_MMA(ai, bj, At, Bt) do { __builtin_amdgcn_s_setprio(1); _Pragma("unroll") for (int m = 0; m < 4; ++m) _Pragma("unroll") for (int n = 0; n < 2; ++n) _Pragma("unroll") for (int k = 0; k < 2; ++k) \
        acc[ai][bj][m][n] = __builtin_amdgcn_mfma_f32_16x16x32_bf16(Bt[n][k], At[m][k], acc[ai][bj][m][n], 0, 0, 0); __builtin_amdgcn_s_setprio(0); } while (0)
#define PG8_WAIT_V(n) asm volatile("s_waitcnt vmcnt(" #n ")" ::: "memory")
#define PG8_WAIT_L(n) asm volatile("s_waitcnt lgkmcnt(" #n ")" ::: "memory")
#define PG8_BAR __builtin_amdgcn_s_barrier()
#define PG8_SCHED __builtin_amdgcn_sched_barrier(0)
    Unit cur, nxt; int ui = 0;
    if (!S.next(0, cur)) return;
    f32x4 acc[2][2][4][2];
#pragma unroll
    for (int a = 0; a < 2; ++a)
#pragma unroll
        for (int b = 0; b < 2; ++b)
#pragma unroll
            for (int m = 0; m < 4; ++m)
#pragma unroll
                for (int n = 0; n < 2; ++n) acc[a][b][m][n] = (f32x4){0.f, 0.f, 0.f, 0.f};
    bf16x8 At[4][2], B0[2][2], B1[2][2];
    const char* cA = (const char*)g.A + (size_t)cur.pm * tstepA; const char* cB = (const char*)g.Bt + (size_t)cur.pn * tstep;
    if constexpr (SP2) {
        PG8_STAGE(PG8_SB(0, 0), cB, voffB); PG8_STAGE(PG8_SB(0, 1), cB + hstep, voffB); PG8_STAGE(PG8_SA(0, 0), cA, voffA); PG8_STAGE(PG8_SA(0, 1), cA + hstepA, voffA);
        if (wr == 1) PG8_BAR;
        PG8_WAIT_V(2); PG8_BAR;
        PG8_STAGE(PG8_SB(1, 0), cB + kstep, voffB); PG8_STAGE(PG8_SA(1, 0), cA + kstep, voffA); PG8_STAGE(PG8_SB(1, 1), cB + hstep + kstep, voffB);
        PG8_WAIT_V(6); PG8_BAR;
    } else {
        PG8_STAGE(PG8_SB(0, 0), cB, voffB); PG8_STAGE(PG8_SA(0, 0), cA, voffA); PG8_STAGE(PG8_SB(0, 1), cB + hstep, voffB); PG8_STAGE(PG8_SA(0, 1), cA + hstepA, voffA);
        if (wr == 1) PG8_BAR;
        PG8_WAIT_V(4); PG8_BAR;
        PG8_STAGE(PG8_SB(1, 0), cB + kstep, voffB); PG8_STAGE(PG8_SA(1, 0), cA + kstep, voffA); PG8_STAGE(PG8_SB(1, 1), cB + hstep + kstep, voffB);
        PG8_WAIT_V(6); PG8_BAR;
    }
    for (;;) {
        const bool has_next = S.next(ui + 1, nxt);
        const char* nA = has_next ? (const char*)g.A + (size_t)nxt.pm * tstepA : cA; const char* nB = has_next ? (const char*)g.Bt + (size_t)nxt.pn * tstep : cB;
        for (int t = 0; t < nt; t += 2) {
            const bool last = (t == nt - 2);
            const char* a1 = cA + (size_t)(t + 1) * kstep;
            const char* a2 = last ? nA : cA + (size_t)(t + 2) * kstep; const char* b2 = last ? nB : cB + (size_t)(t + 2) * kstep;
            const char* a3 = a2 + kstep; const char* b3 = b2 + kstep;
            if constexpr (SP2) {
            PG8_LDB(B0, 0, 0); PG8_LDB(B1, 0, 1); PG8_SCHED; PG8_LDA(At, 0, 0); PG8_STAGE(PG8_SA(1, 1), a1 + hstepA, voffA);
            PG8_WAIT_V(8); PG8_WAIT_L(0); PG8_BAR; PG8_MMA(0, 0, At, B0); PG8_MMA(0, 1, At, B1); PG8_BAR; PG8_SCHED;
            PG8_LDA(At, 0, 1); PG8_STAGE(PG8_SB(0, 0), b2, voffB); PG8_STAGE(PG8_SB(0, 1), b2 + hstep, voffB); PG8_STAGE(PG8_SA(0, 0), a2, voffA);
            PG8_WAIT_V(8); PG8_WAIT_L(0); PG8_BAR; PG8_MMA(1, 0, At, B0); PG8_MMA(1, 1, At, B1); PG8_BAR; PG8_SCHED;
            PG8_LDB(B0, 1, 0); PG8_LDB(B1, 1, 1); PG8_SCHED; PG8_LDA(At, 1, 0); PG8_STAGE(PG8_SA(0, 1), a2 + hstepA, voffA);
            PG8_WAIT_V(8); PG8_WAIT_L(0); PG8_BAR; PG8_MMA(0, 0, At, B0); PG8_MMA(0, 1, At, B1); PG8_BAR; PG8_SCHED;
            PG8_LDA(At, 1, 1); PG8_STAGE(PG8_SB(1, 0), b3, voffB); PG8_STAGE(PG8_SB(1, 1), b3 + hstep, voffB); PG8_STAGE(PG8_SA(1, 0), a3, voffA);
            PG8_WAIT_V(8); PG8_WAIT_L(0); PG8_BAR; PG8_MMA(1, 0, At, B0); PG8_MMA(1, 1, At, B1); PG8_BAR; PG8_SCHED;
            } else {
            PG8_LDB(B0, 0, 0); PG8_SCHED; PG8_LDA(At, 0, 0); PG8_STAGE(PG8_SA(1, 1), a1 + hstepA, voffA);
            PG8_WAIT_L(8); PG8_BAR; PG8_WAIT_L(0); PG8_MMA(0, 0, At, B0); PG8_BAR; PG8_SCHED;
            PG8_LDB(B1, 0, 1); PG8_STAGE(PG8_SB(0, 0), b2, voffB);
            PG8_BAR; PG8_WAIT_L(0); PG8_MMA(0, 1, At, B1); PG8_BAR;
            PG8_LDA(At, 0, 1); PG8_STAGE(PG8_SA(0, 0), a2, voffA);
            PG8_BAR; PG8_WAIT_L(0); PG8_MMA(1, 0, At, B0); PG8_BAR; PG8_SCHED;
            PG8_STAGE(PG8_SB(0, 1), b2 + hstep, voffB);
            PG8_WAIT_V(6); PG8_BAR; PG8_MMA(1, 1, At, B1); PG8_BAR;
            PG8_LDB(B0, 1, 0); PG8_SCHED; PG8_LDA(At, 1, 0); PG8_STAGE(PG8_SA(0, 1), a2 + hstepA, voffA);
            PG8_WAIT_L(8); PG8_BAR; PG8_WAIT_L(0); PG8_MMA(0, 0, At, B0); PG8_BAR; PG8_SCHED;
            PG8_LDB(B1, 1, 1); PG8_STAGE(PG8_SB(1, 0), b3, voffB);
            PG8_BAR; PG8_WAIT_L(0); PG8_MMA(0, 1, At, B1); PG8_BAR;
            PG8_LDA(At, 1, 1); PG8_STAGE(PG8_SA(1, 0), a3, voffA);
            PG8_BAR; PG8_WAIT_L(0); PG8_MMA(1, 0, At, B0); PG8_BAR; PG8_SCHED;
            PG8_STAGE(PG8_SB(1, 1), b3 + hstep, voffB);
            PG8_WAIT_V(6); PG8_BAR; PG8_MMA(1, 1, At, B1); PG8_BAR;
            }
        }
        if constexpr (ALIGN_EPI) { if (wr == 0) PG8_BAR; }
        { const int t2 = otid(), l2 = t2 & 63; E(acc, cur, wr, (t2 >> 6) & 3, l2 & 15, l2 >> 4); }
        if (!has_next) break;
#pragma unroll
        for (int a = 0; a < 2; ++a)
#pragma unroll
            for (int b = 0; b < 2; ++b)
#pragma unroll
                for (int m = 0; m < 4; ++m)
#pragma unroll
                    for (int n = 0; n < 2; ++n) acc[a][b][m][n] = (f32x4){0.f, 0.f, 0.f, 0.f};
        cur = nxt; cA = nA; cB = nB; ++ui;
        if constexpr (ALIGN_EPI) { if (wr == 1) PG8_BAR; }
    }
    PG8_WAIT_V(0);
    if constexpr (!ALIGN_EPI) { if (wr == 0) PG8_BAR; }
    PG8_BAR;
#undef PG8_SA
#undef PG8_SB
#undef PG8_STAGE
#undef PG8_LDA
#undef PG8_LDB
#undef PG8_MMA
#undef PG8_WAIT_V
#undef PG8_WAIT_L
#undef PG8_BAR
#undef PG8_SCHED
}
}

struct EpiSwiglu {
    static constexpr bool PERM = true;
    bf16_t* H;
    DI void operator()(const f32x4 (&acc)[2][2][4][2], const pg8::Unit& u, int wr, int wc, int fr, int fq) const {
        const int row0 = u.pm * 256 + wr * 64 + fr, col0 = u.pn * 128 + wc * 32 + 8 * fq;
#pragma unroll
        for (int ai = 0; ai < 2; ++ai)
#pragma unroll
            for (int m = 0; m < 4; ++m) {
                bf16_t* rowp = H + (size_t)(row0 + ai * 128 + m * 16) * FF_ + col0;
                float h[8];
#pragma unroll
                for (int n = 0; n < 2; ++n)
#pragma unroll
                    for (int j = 0; j < 4; ++j) { const float gg = acc[ai][0][m][n][j], uu = acc[ai][1][m][n][j]; h[n * 4 + j] = siluf_(gg) * uu; }
                u32x4 w; w.x = cvt_pk_bf16(h[0], h[1]); w.y = cvt_pk_bf16(h[2], h[3]); w.z = cvt_pk_bf16(h[4], h[5]); w.w = cvt_pk_bf16(h[6], h[7]);
                *(u32x4*)rowp = w;
            }
    }
};
template <bool HAS_RES> struct EpiResid {
    static constexpr bool PERM = true;
    const float* res; bf16_t* out; const bf16_t* resb; int half;
    DI void operator()(const f32x4 (&acc)[2][2][4][2], const pg8::Unit& u, int wr, int wc, int fr, int fq) const {
        const int row0 = u.pm * 256 + wr * 64 + fr, col0 = u.pn * 256 + wc * 32 + 8 * fq;
        const float sc = half ? 0.5f : 1.0f;
#pragma unroll
        for (int ai = 0; ai < 2; ++ai)
#pragma unroll
            for (int m = 0; m < 4; ++m) {
                const size_t off = (size_t)(row0 + ai * 128 + m * 16) * D_ + col0;
#pragma unroll
                for (int bj = 0; bj < 2; ++bj) {
                    const size_t o = off + bj * 128;
                    f32x4 v0 = acc[ai][bj][m][0] * sc, v1 = acc[ai][bj][m][1] * sc;
                    if (HAS_RES) {
                        f32x4 r0, r1;
                        if (resb) { const u32x4 rb = *(const u32x4*)(resb + o); r0 = (f32x4){bflo(rb.x), bfhi(rb.x), bflo(rb.y), bfhi(rb.y)}; r1 = (f32x4){bflo(rb.z), bfhi(rb.z), bflo(rb.w), bfhi(rb.w)}; }
                        else { r0 = *(const f32x4*)(res + o); r1 = *(const f32x4*)(res + o + 4); }
                        v0 = v0 + r0 * DN_ALPHA; v1 = v1 + r1 * DN_ALPHA;
                    }
                    u32x4 w; w.x = cvt_pk_bf16(v0[0], v0[1]); w.y = cvt_pk_bf16(v0[2], v0[3]); w.z = cvt_pk_bf16(v1[0], v1[1]); w.w = cvt_pk_bf16(v1[2], v1[3]);
                    *(u32x4*)(out + o) = w;
                }
            }
    }
};
struct EpiProj {
    static constexpr bool PERM = true;
    bf16_t* O; int ldc; int n_main; float* gb;
    DI void operator()(const f32x4 (&acc)[2][2][4][2], const pg8::Unit& u, int wr, int wc, int fr, int fq) const {
        const int row0 = u.pm * 256 + wr * 64 + fr;
        if (u.pn < n_main) {
            const int col0 = u.pn * 256 + wc * 32 + 8 * fq;
#pragma unroll
            for (int ai = 0; ai < 2; ++ai)
#pragma unroll
                for (int m = 0; m < 4; ++m) {
                    bf16_t* rowp = O + (size_t)(row0 + ai * 128 + m * 16) * ldc + col0;
#pragma unroll
                    for (int bj = 0; bj < 2; ++bj) {
                        const f32x4 v0 = acc[ai][bj][m][0], v1 = acc[ai][bj][m][1];
                        u32x4 w; w.x = cvt_pk_bf16(v0[0], v0[1]); w.y = cvt_pk_bf16(v0[2], v0[3]); w.z = cvt_pk_bf16(v1[0], v1[1]); w.w = cvt_pk_bf16(v1[2], v1[3]);
                        *(u32x4*)(rowp + bj * 128) = w;
                    }
                }
        } else if (wc == 0 && fq < 2) {
#pragma unroll
            for (int ai = 0; ai < 2; ++ai)
#pragma unroll
                for (int m = 0; m < 4; ++m) {
                    float* rp = gb + (size_t)(row0 + ai * 128 + m * 16) * 16 + 8 * fq;
                    *(f32x4*)rp = acc[ai][0][m][0]; *(f32x4*)(rp + 4) = acc[ai][0][m][1];
                }
        }
    }
};
struct EpiPle {
    static constexpr bool PERM = true;
    const bf16_t* xb; const bf16_t* pp; const float* bg; float* out; bf16_t* xbn;
    DI void operator()(const f32x4 (&acc)[2][2][4][2], const pg8::Unit& u, int wr, int wc, int fr, int fq) const {
        const int row0 = u.pm * 256 + wr * 64 + fr, col0 = u.pn * 256 + wc * 32 + 8 * fq;
#pragma unroll
        for (int ai = 0; ai < 2; ++ai)
#pragma unroll
            for (int m = 0; m < 4; ++m) {
                const size_t off = (size_t)(row0 + ai * 128 + m * 16) * D_ + col0;
#pragma unroll
                for (int bj = 0; bj < 2; ++bj) {
                    const size_t o = off + bj * 128;
                    const f32x4 b0 = *(const f32x4*)(bg + col0 + bj * 128), b1 = *(const f32x4*)(bg + col0 + bj * 128 + 4);
                    const u32x4 rb = *(const u32x4*)(xb + o);
                    const u32x4 pb = *(const u32x4*)(pp + o);
                    const f32x4 x0 = (f32x4){bflo(rb.x), bfhi(rb.x), bflo(rb.y), bfhi(rb.y)}, x1 = (f32x4){bflo(rb.z), bfhi(rb.z), bflo(rb.w), bfhi(rb.w)};
                    const f32x4 p0 = (f32x4){bflo(pb.x), bfhi(pb.x), bflo(pb.y), bfhi(pb.y)}, p1 = (f32x4){bflo(pb.z), bfhi(pb.z), bflo(pb.w), bfhi(pb.w)};
                    f32x4 v0, v1;
#pragma unroll
                    for (int j = 0; j < 4; ++j) { v0[j] = x0[j] + sigmoidf_(acc[ai][bj][m][0][j] + b0[j]) * p0[j]; v1[j] = x1[j] + sigmoidf_(acc[ai][bj][m][1][j] + b1[j]) * p1[j]; }
                    if (out) { *(f32x4*)(out + o) = v0; *(f32x4*)(out + o + 4) = v1; }
                    if (xbn) { u32x4 w; w.x = cvt_pk_bf16(v0[0], v0[1]); w.y = cvt_pk_bf16(v0[2], v0[3]); w.z = cvt_pk_bf16(v1[0], v1[1]); w.w = cvt_pk_bf16(v1[2], v1[3]); *(u32x4*)(xbn + o) = w; }
                }
            }
    }
};

DI void conv_plain(const float* src, bf16_t* dst, size_t n) {
    const size_t stride = (size_t)gridDim.x * NTHREADS * 8;
    for (size_t i = ((size_t)blockIdx.x * NTHREADS + otid()) * 8; i < n; i += stride) {
        const f32x4 a = *(const f32x4*)(src + i), b = *(const f32x4*)(src + i + 4);
        u32x4 w; w.x = pk2(a[0], a[1]); w.y = pk2(a[2], a[3]); w.z = pk2(b[0], b[1]); w.w = pk2(b[2], b[3]);
        *(u32x4*)(dst + i) = w;
    }
}
DI void conv_T(const float* src, int K, int N, bf16_t* dst, int grp, int gstride, int goff, LAS float* tile) {
    const int tid = otid();
    const int ntn = (N + 63) / 64, ntk = K / 64, ntile = ntn * ntk;
    const int kk0 = tid >> 4, n4 = (tid & 15) * 4;
    f32x4 v[2];
    int t = blockIdx.x;
    if (t < ntile) {
        const int k0 = (t / ntn) * 64, n = (t % ntn) * 64 + n4;
#pragma unroll
        for (int p = 0; p < 2; ++p) v[p] = (n < N) ? *(const f32x4*)(src + (size_t)(k0 + kk0 + 32 * p) * N + n) : (f32x4){0.f, 0.f, 0.f, 0.f};
    }
    for (; t < ntile; t += gridDim.x) {
        const int k0 = (t / ntn) * 64, n0 = (t % ntn) * 64;
#pragma unroll
        for (int p = 0; p < 2; ++p) {
            const int kk = kk0 + 32 * p;
            tile[kk * 65 + n4 + 0] = v[p][0]; tile[kk * 65 + n4 + 1] = v[p][1]; tile[kk * 65 + n4 + 2] = v[p][2]; tile[kk * 65 + n4 + 3] = v[p][3];
        }
        const int tn_ = t + gridDim.x;
        if (tn_ < ntile) {
            const int k1 = (tn_ / ntn) * 64, n = (tn_ % ntn) * 64 + n4;
#pragma unroll
            for (int p = 0; p < 2; ++p) v[p] = (n < N) ? *(const f32x4*)(src + (size_t)(k1 + kk0 + 32 * p) * N + n) : (f32x4){0.f, 0.f, 0.f, 0.f};
        }
        lds_barrier();
        {
            const int nn = tid >> 3, k8 = (tid & 7) * 8, n = n0 + nn;
            if (n < N) {
                float x[8];
#pragma unroll
                for (int j = 0; j < 8; ++j) x[j] = tile[(k8 + j) * 65 + nn];
                u32x4 w; w.x = pk2(x[0], x[1]); w.y = pk2(x[2], x[3]); w.z = pk2(x[4], x[5]); w.w = pk2(x[6], x[7]);
                const size_t row = (size_t)(n / grp) * gstride + (n % grp) + goff;
                *(u32x4*)(dst + row * K + k0 + k8) = w;
            }
        }
        lds_barrier();
    }
}

DI void phase_convert(const Params& P, LAS unsigned char* lds) {
    LAS float* tile = (LAS float*)lds;
    bf16_t* W = (bf16_t*)P.ws;
    for (int l = 0; l < 2; ++l)
        for (int w = 0; w < 2; ++w) {
            bf16_t* up = (bf16_t*)(P.ws + W_FFN + (size_t)(l * 2 + w) * (SZ_UP + SZ_DN));
            bf16_t* dn = (bf16_t*)((unsigned char*)up + SZ_UP);
            const float* wg = P.in[w ? 5 : 2] + (size_t)l * D_ * FF_;
            const float* wu = P.in[w ? 6 : 3] + (size_t)l * D_ * FF_;
            const float* wd = P.in[w ? 7 : 4] + (size_t)l * FF_ * D_;
            conv_T(wg, D_, FF_, up, 128, 256, 0, tile);
            conv_T(wu, D_, FF_, up, 128, 256, 128, tile);
            conv_T(wd, FF_, D_, dn, 1 << 30, 0, 0, tile);
        }
    for (int l = 0; l < 2; ++l) {
        bf16_t* g = (bf16_t*)(P.ws + W_PLE + (size_t)l * SZ_PLE);
        bf16_t* pw = (bf16_t*)((unsigned char*)g + 2097152);
        conv_T(P.in[10] + (size_t)l * D_ * D_, D_, D_, g, 1 << 30, 0, 0, tile);
        conv_T(P.in[12] + (size_t)l * 256 * D_, 256, D_, pw, 1 << 30, 0, 0, tile);
    }
    conv_T(P.in[13], D_, 1792, (bf16_t*)(P.ws + W_AB_IN), 1 << 30, 0, 0, tile);
    conv_T(P.in[22], D_, D_, (bf16_t*)(P.ws + W_AB_OUT), 1 << 30, 0, 0, tile);
    conv_T(P.in[23], D_, 4112, (bf16_t*)(P.ws + W_C_IN), 1 << 30, 0, 0, tile);
    conv_T(P.in[28], D_, D_, (bf16_t*)(P.ws + W_C_OUT), 1 << 30, 0, 0, tile);
    for (int hb = 0; hb < 8; ++hb) {
        conv_T(P.in[17] + hb * 4096, 64, 64, (bf16_t*)(P.ws + W_WA) + hb * 4096, 1 << 30, 0, 0, tile);
        conv_T(P.in[19] + hb * 4096, 64, 64, (bf16_t*)(P.ws + W_WX) + hb * 4096, 1 << 30, 0, 0, tile);
    }
    conv_plain(P.in[0], (bf16_t*)(P.ws + WS_XB0), (size_t)T_ * D_);
    conv_plain(P.in[1], (bf16_t*)(P.ws + WS_PB), (size_t)T_ * 256);
    (void)W;
}

template <int CTRL> DI float dppf(float v) { return __builtin_bit_cast(float, __builtin_amdgcn_update_dpp(0, __builtin_bit_cast(int, v), CTRL, 0xF, 0xF, true)); }
DI float row16_sum(float v) { v += dppf<0xB1>(v); v += dppf<0x4E>(v); v += dppf<0x141>(v); v += dppf<0x140>(v); return v; }
DI float row16_max(float v) { v = fmaxf(v, dppf<0xB1>(v)); v = fmaxf(v, dppf<0x4E>(v)); v = fmaxf(v, dppf<0x141>(v)); v = fmaxf(v, dppf<0x140>(v)); return v; }
DI float rdlane(float v, int l) { return __builtin_bit_cast(float, __builtin_amdgcn_readlane(__builtin_bit_cast(int, v), l)); }
DI float wave_sum(float v) { v = row16_sum(v); return (rdlane(v, 0) + rdlane(v, 16)) + (rdlane(v, 32) + rdlane(v, 48)); }
DI void phase_ln(const bf16_t* vin, float* xf, bf16_t* xb, const float* g, const float* b, bool write_f32) {
    const int tid = otid(), wave = tid >> 6, lane = tid & 63;
    f32x4 gv[4], bv[4];
#pragma unroll
    for (int i = 0; i < 4; ++i) { gv[i] = *(const f32x4*)(g + i * 256 + lane * 4); bv[i] = *(const f32x4*)(b + i * 256 + lane * 4); }
    const int nw = gridDim.x * 8;
    constexpr int R = 4;
    for (int r0 = blockIdx.x * 8 + wave; r0 < T_; r0 += nw * R) {
        f32x4 v[R][4];
#pragma unroll
        for (int k = 0; k < R; ++k) {
            const bf16_t* row = vin + (size_t)(r0 + k * nw) * D_;
#pragma unroll
            for (int i = 0; i < 4; ++i) { const u32x2 w = *(const u32x2*)(row + i * 256 + lane * 4); v[k][i] = (f32x4){bflo(w.x), bfhi(w.x), bflo(w.y), bfhi(w.y)}; }
        }
#pragma unroll
        for (int k = 0; k < R; ++k) {
            float s = 0.f;
#pragma unroll
            for (int i = 0; i < 4; ++i) s += (v[k][i][0] + v[k][i][1]) + (v[k][i][2] + v[k][i][3]);
            const float mean = wave_sum(s) * (1.0f / 1024.0f);
            float q = 0.f;
#pragma unroll
            for (int i = 0; i < 4; ++i) { const f32x4 d = v[k][i] - mean; q += (d[0] * d[0] + d[1] * d[1]) + (d[2] * d[2] + d[3] * d[3]); }
            const float rstd = rsqrtf(wave_sum(q) * (1.0f / 1024.0f) + 1e-5f);
            float* row = xf + (size_t)(r0 + k * nw) * D_;
            bf16_t* rb = xb + (size_t)(r0 + k * nw) * D_;
#pragma unroll
            for (int i = 0; i < 4; ++i) {
                const f32x4 o = (v[k][i] - mean) * rstd * gv[i] + bv[i];
                if (write_f32) *(f32x4*)(row + i * 256 + lane * 4) = o;
                u32x2 w; w.x = pk2(o[0], o[1]); w.y = pk2(o[2], o[3]);
                *(u32x2*)(rb + i * 256 + lane * 4) = w;
            }
        }
    }
}

constexpr int PJ0 = 1792;
DI void attn_unit(const bf16_t* proj, bf16_t* ycat, const float* sinks, int b, int n, int kvh, LAS unsigned char* lds) {
    constexpr int KS_OFF = 0, VT_OFF = 27648, PS_OFF = 53248;
    const int tid = otid(), wave = tid >> 6, lane = tid & 63, fr = lane & 15, fq = lane >> 4;
    u32x4 kva[3], vva[3];
#pragma unroll
    for (int it = 0; it < 3; ++it) {
        const int idx = tid + NTHREADS * it, s = idx >> 3, d8 = idx & 7;
        const int pos = (n - 2) * 64 + s;
        kva[it] = (u32x4){0u, 0u, 0u, 0u}; vva[it] = (u32x4){0u, 0u, 0u, 0u};
        if (pos >= 0) {
            const bf16_t* rp = proj + (size_t)(b * SEQ_ + pos) * PJ0;
            kva[it] = *(const u32x4*)(rp + 512 + kvh * 64 + d8 * 8);
            vva[it] = *(const u32x4*)(rp + 640 + kvh * 64 + d8 * 8);
        }
    }
    bf16x8 qall[2][2];
    {
        const int g_ = wave >> 1, hh_ = kvh * 4 + g_, rh_ = wave & 1;
#pragma unroll
        for (int rt = 0; rt < 2; ++rt)
#pragma unroll
            for (int ks = 0; ks < 2; ++ks)
                qall[rt][ks] = *(const bf16x8*)(proj + (size_t)(b * SEQ_ + n * 64 + rh_ * 32 + rt * 16 + fr) * PJ0 + hh_ * 64 + ks * 32 + fq * 8);
    }
#pragma unroll
    for (int it = 0; it < 3; ++it) {
        const int idx = tid + NTHREADS * it, s = idx >> 3, d8 = idx & 7;
        const u32x4 kv = kva[it], vv = vva[it];
        *(LAS u32x4*)(lds + KS_OFF + s * 144 + d8 * 16) = kv;
        const unsigned vw[4] = {vv.x, vv.y, vv.z, vv.w};
#pragma unroll
        for (int j = 0; j < 4; ++j) {
            *(LAS bf16_t*)(lds + VT_OFF + (d8 * 8 + 2 * j) * 400 + s * 2) = (bf16_t)(vw[j] & 0xffffu);
            *(LAS bf16_t*)(lds + VT_OFF + (d8 * 8 + 2 * j + 1) * 400 + s * 2) = (bf16_t)(vw[j] >> 16);
        }
    }
    __syncthreads();
    const int g = wave >> 1, hh = kvh * 4 + g, rh = wave & 1;
    const float slope = exp2f(-(float)(hh + 1)), sink = sinks[hh];
    LAS unsigned char* Ps = lds + PS_OFF + wave * 6400;
    for (int rt = 0; rt < 2; ++rt) {
        const int c0 = rh * 32 + rt * 16;
        bf16x8 qa[2];
#pragma unroll
        for (int ks = 0; ks < 2; ++ks) qa[ks] = (rt == 0) ? qall[0][ks] : qall[1][ks];
        f32x4 sc[12];
#pragma unroll
        for (int kt = 0; kt < 12; ++kt) {
            f32x4 a = (f32x4){0.f, 0.f, 0.f, 0.f};
#pragma unroll
            for (int ks = 0; ks < 2; ++ks) a = MFMA16(qa[ks], ldsfrag(lds + KS_OFF + (kt * 16 + fr) * 144 + (ks * 32 + fq * 8) * 2), a);
            sc[kt] = a;
        }
        float mx[4] = {-3.0e38f, -3.0e38f, -3.0e38f, -3.0e38f};
#pragma unroll
        for (int kt = 0; kt < 12; ++kt) {
            const int s = kt * 16 + fr;
            const bool valid = ((n - 2) * 64 + s) >= 0;
#pragma unroll
            for (int j = 0; j < 4; ++j) {
                const int c = c0 + fq * 4 + j;
                const float dist = fabsf((float)(c + 128 - s));
                const float v = valid ? (sc[kt][j] * 0.125f - slope * dist) : -3.0e38f;
                sc[kt][j] = v; mx[j] = fmaxf(mx[j], v);
            }
        }
        float den[4];
#pragma unroll
        for (int j = 0; j < 4; ++j) {
            float m = mx[j];
            m = row16_max(m);
            m = fmaxf(m, sink); mx[j] = m;
            float ssum = 0.f;
#pragma unroll
            for (int kt = 0; kt < 12; ++kt) { const float p = (sc[kt][j] > -1.0e38f) ? __expf(sc[kt][j] - m) : 0.f; sc[kt][j] = p; ssum += p; }
            ssum = row16_sum(ssum);
            den[j] = 1.0f / (ssum + __expf(sink - m));
        }
#pragma unroll
        for (int kt = 0; kt < 12; ++kt)
#pragma unroll
            for (int j = 0; j < 4; ++j) *(LAS bf16_t*)(Ps + (fq * 4 + j) * 400 + (kt * 16 + fr) * 2) = (bf16_t)f2bf(sc[kt][j] * den[j]);
        __syncthreads();
#pragma unroll
        for (int dt = 0; dt < 4; ++dt) {
            f32x4 o = (f32x4){0.f, 0.f, 0.f, 0.f};
#pragma unroll
            for (int ks = 0; ks < 6; ++ks)
                o = MFMA16(ldsfrag(Ps + fr * 400 + (ks * 32 + fq * 8) * 2), ldsfrag(lds + VT_OFF + (dt * 16 + fr) * 400 + (ks * 32 + fq * 8) * 2), o);
#pragma unroll
            for (int j = 0; j < 4; ++j)
                ycat[(size_t)(b * SEQ_ + n * 64 + c0 + fq * 4 + j) * D_ + hh * 64 + dt * 16 + fr] = (bf16_t)f2bf(o[j]);
        }
        __syncthreads();
    }
}

DI void rglru_unit(const Params& P, const bf16_t* proj, bf16_t* ycat, int b, int hb, LAS unsigned char* lds) {
    constexpr int WA_OFF = 0, WX_OFF = 9216, BXC_OFF = 18432, BXF_OFF = 27648, A_OFF = 44032, U_OFF = 60416;
    const int tid = otid(), wave = tid >> 6, lane = tid & 63, fr = lane & 15, fq = lane >> 4;
    {
        const int j = tid >> 3, c8 = tid & 7;
        *(LAS u32x4*)(lds + WA_OFF + j * 144 + c8 * 16) = *(const u32x4*)((const bf16_t*)(P.ws + W_WA) + hb * 4096 + j * 64 + c8 * 8);
        *(LAS u32x4*)(lds + WX_OFF + j * 144 + c8 * 16) = *(const u32x4*)((const bf16_t*)(P.ws + W_WX) + hb * 4096 + j * 64 + c8 * 8);
    }
    const int ch = tid & 63, tg = tid >> 6;
    float cw[4];
#pragma unroll
    for (int j = 0; j < 4; ++j) cw[j] = P.in[15][j * 512 + hb * 64 + ch];
    const float cb = P.in[16][hb * 64 + ch];
    const int tr = wave >> 1, ctb = 2 * (wave & 1);
    float ba[2], bxb[2], spl[2];
#pragma unroll
    for (int c = 0; c < 2; ++c) { const int cc = hb * 64 + (ctb + c) * 16 + fr; ba[c] = P.in[18][cc]; bxb[c] = P.in[20][cc]; spl[c] = softplusf_(-P.in[21][cc]); }
    float hstate = 0.f;
    LAS float* BXF = (LAS float*)(lds + BXF_OFF); LAS float* AA = (LAS float*)(lds + A_OFF); LAS float* UU = (LAS float*)(lds + U_OFF);
    unsigned rawn[11], bgrn[8];
#pragma unroll
    for (int i = 0; i < 11; ++i) { const int sp = tg * 8 - 3 + i; rawn[i] = (sp >= 0) ? (unsigned)proj[(size_t)(b * SEQ_ + sp) * PJ0 + 768 + hb * 64 + ch] : 0u; }
#pragma unroll
    for (int i = 0; i < 8; ++i) bgrn[i] = proj[(size_t)(b * SEQ_ + tg * 8 + i) * PJ0 + 1280 + hb * 64 + ch];
#pragma unroll 1
    for (int n = 0; n < 32; ++n) {
        const int t0 = b * SEQ_ + n * 64;
        float raw[11]; unsigned bgr[8];
#pragma unroll
        for (int i = 0; i < 11; ++i) raw[i] = bf2f(rawn[i]);
#pragma unroll
        for (int i = 0; i < 8; ++i) bgr[i] = bgrn[i];
        if (n + 1 < 32) {
#pragma unroll
            for (int i = 0; i < 11; ++i) rawn[i] = proj[(size_t)(t0 + 64 + tg * 8 - 3 + i) * PJ0 + 768 + hb * 64 + ch];
#pragma unroll
            for (int i = 0; i < 8; ++i) bgrn[i] = proj[(size_t)(t0 + 64 + tg * 8 + i) * PJ0 + 1280 + hb * 64 + ch];
        }
#pragma unroll
        for (int i = 0; i < 8; ++i) {
            const float v = cb + cw[0] * raw[i] + cw[1] * raw[i + 1] + cw[2] * raw[i + 2] + cw[3] * raw[i + 3];
            const int tok = tg * 8 + i;
            BXF[tok * 64 + ch] = v;
            *(LAS bf16_t*)(lds + BXC_OFF + tok * 144 + ch * 2) = (bf16_t)f2bf(v);
        }
        lds_barrier();
        {
            bf16x8 af[2];
#pragma unroll
            for (int ks = 0; ks < 2; ++ks) af[ks] = ldsfrag(lds + BXC_OFF + (tr * 16 + fr) * 144 + (ks * 32 + fq * 8) * 2);
#pragma unroll
            for (int c = 0; c < 2; ++c) {
                const int ct = ctb + c;
                f32x4 ga = (f32x4){0.f, 0.f, 0.f, 0.f}, gx = (f32x4){0.f, 0.f, 0.f, 0.f};
#pragma unroll
                for (int ks = 0; ks < 2; ++ks) {
                    ga = MFMA16(af[ks], ldsfrag(lds + WA_OFF + (ct * 16 + fr) * 144 + (ks * 32 + fq * 8) * 2), ga);
                    gx = MFMA16(af[ks], ldsfrag(lds + WX_OFF + (ct * 16 + fr) * 144 + (ks * 32 + fq * 8) * 2), gx);
                }
#pragma unroll
                for (int j = 0; j < 4; ++j) {
                    const int tok = tr * 16 + fq * 4 + j, cc = ct * 16 + fr;
                    const float r = sigmoidf_(ga[j] + ba[c]), ig = sigmoidf_(gx[j] + bxb[c]);
                    const float la = -8.0f * r * spl[c];
                    const float a = __expf(la);
                    const float mult = sqrtf(fmaxf(-expm1_neg(2.0f * la), 0.f));
                    AA[tok * 64 + cc] = a;
                    UU[tok * 64 + cc] = mult * ig * BXF[tok * 64 + cc];
                }
            }
        }
        lds_barrier();
        if (wave == 0) {
#pragma unroll 1
            for (int t8 = 0; t8 < 64; t8 += 8) {
                float av[8], uv[8];
#pragma unroll
                for (int k = 0; k < 8; ++k) { av[k] = AA[(t8 + k) * 64 + lane]; uv[k] = UU[(t8 + k) * 64 + lane]; }
                __builtin_amdgcn_sched_barrier(0);
#pragma unroll
                for (int k = 0; k < 8; ++k) { hstate = av[k] * hstate + uv[k]; uv[k] = hstate; }
#pragma unroll
                for (int k = 0; k < 8; ++k) UU[(t8 + k) * 64 + lane] = uv[k];
            }
        }
        lds_barrier();
#pragma unroll
        for (int i = 0; i < 8; ++i) {
            const int tok = tg * 8 + i;
            const float y = UU[tok * 64 + ch] * gelu_tanh(bf2f(bgr[i]));
            ycat[(size_t)(t0 + tok) * D_ + 512 + hb * 64 + ch] = (bf16_t)f2bf(y);
        }
    }
    __syncthreads();
}

DI void phase_mixer0(const Params& P, LAS unsigned char* lds, const bf16_t* proj, bf16_t* ycat) {
    for (int u = blockIdx.x; u < 256; u += gridDim.x) rglru_unit(P, proj, ycat, u >> 3, u & 7, lds);
    for (int u = blockIdx.x; u < 2048; u += gridDim.x) { const int kvh = u & 1, n = (u >> 1) & 31, b = u >> 6; attn_unit(proj, ycat, P.in[14], b, n, kvh, lds); }
}

constexpr int PJ1 = 4096;
DI void gdn_unit(const Params& P, bf16_t* proj, const float* gb, int b, int h, LAS unsigned char* lds) {
    constexpr int Q_OFF = 0, K_OFF = 17408, KT_OFF = 34816, X_OFF = 53248, ST_OFF = 90112, ATT_OFF = 124928, L_OFF = 134144, MISC_OFF = 150528;
    constexpr int VT_OFF = X_OFF, TP_OFF = X_OFF + 18432, TPP_OFF = X_OFF + 27648, VN_OFF = X_OFF, VNS_OFF = X_OFF + 18432;
    const int tid = otid(), wave = __builtin_amdgcn_readfirstlane(tid >> 6), lane0 = tid & 63;
    LAS float* Lm = (LAS float*)(lds + L_OFF);
    LAS float* gcs = (LAS float*)(lds + MISC_OFF); LAS float* betas = gcs + 64; LAS float* egcs = gcs + 128; LAS float* djs = gcs + 192; LAS float* part = gcs + 256;
    for (int i = tid; i < 34816 / 4; i += NTHREADS) *(LAS unsigned*)(lds + ST_OFF + i * 4) = 0u;
    f32x4 Sacc[8];
#pragma unroll
    for (int i = 0; i < 8; ++i) Sacc[i] = (f32x4){0.f, 0.f, 0.f, 0.f};
    const float Aneg = -__expf(P.in[25][h]), dtb = P.in[26][h];
    const float ng = P.in[27][16 * wave + (lane0 & 15)];
    const float* cwp = P.in[24] + h * 128 + 2 * lane0;
    __syncthreads();
    f32x2 cwr[3][4];
#pragma unroll
    for (int w = 0; w < 3; ++w)
#pragma unroll
        for (int j = 0; j < 4; ++j) cwr[w][j] = *(const f32x2*)(cwp + j * 3072 + w * 1024);
    unsigned rawq[3][11]; float gbl, gai;
    {
        const int t00 = b * SEQ_;
#pragma unroll
        for (int w = 0; w < 3; ++w) {
            const bf16_t* rbase = proj + (size_t)(t00 + wave * 8 - 3) * PJ1 + w * 1024 + h * 128;
#pragma unroll
            for (int i = 0; i < 11; ++i) rawq[w][i] = (wave * 8 - 3 + i >= 0) ? *(const unsigned*)(rbase + i * PJ1 + 2 * lane0) : 0u;
        }
        gbl = gb[(size_t)(t00 + lane0) * 16 + h]; gai = gb[(size_t)(t00 + lane0) * 16 + 8 + h];
    }
#pragma unroll 1
    for (int n = 0; n < 32; ++n) {
        int lane = lane0; asm volatile("" : "+v"(lane));
        const int fr = lane & 15, fq = lane >> 4;
        const int t0 = b * SEQ_ + n * 64;
        float beta, gc, gc_last, egc;
        {
            const float bl = gbl, ai = gai;
            beta = sigmoidf_(bl);
            gc = Aneg * softplusf_(ai + dtb);
#pragma unroll
            for (int o = 1; o < 64; o <<= 1) { const float t = __shfl_up(gc, o); if (lane >= o) gc += t; }
            gc_last = rdlane(gc, 63);
            egc = __expf(gc);
            if (wave == 0) { gcs[lane] = gc; betas[lane] = beta; egcs[lane] = egc; djs[lane] = __expf(gc_last - gc); }
        }
#pragma unroll
        for (int w = 0; w < 3; ++w) {
            const f32x2 (&cw)[4] = cwr[w];
            const unsigned (&raw)[11] = rawq[w];
            float o0[8], o1[8];
#pragma unroll
            for (int i = 0; i < 8; ++i) {
                float a0 = 0.f, a1 = 0.f;
#pragma unroll
                for (int j = 0; j < 4; ++j) { a0 += cw[j][0] * bflo(raw[i + j]); a1 += cw[j][1] * bfhi(raw[i + j]); }
                a0 = siluf_(a0); a1 = siluf_(a1);
                if (w < 2) {
                    const float ss = wave_sum(a0 * a0 + a1 * a1);
                    const float rs = rsqrtf(ss + 1e-6f) * (w == 0 ? 0.08838834764831845f : 1.0f);
                    a0 *= rs; a1 *= rs;
                }
                o0[i] = a0; o1[i] = a1;
            }
            if (w < 2) {
                const int off = (w == 0) ? Q_OFF : K_OFF;
#pragma unroll
                for (int i = 0; i < 8; ++i) *(LAS unsigned*)(lds + off + (wave * 8 + i) * 272 + lane * 4) = pk2(o0[i], o1[i]);
            }
            if (w >= 1) {
                const int off = (w == 1) ? KT_OFF : VT_OFF;
                u32x4 w0, w1;
                w0.x = pk2(o0[0], o0[1]); w0.y = pk2(o0[2], o0[3]); w0.z = pk2(o0[4], o0[5]); w0.w = pk2(o0[6], o0[7]);
                w1.x = pk2(o1[0], o1[1]); w1.y = pk2(o1[2], o1[3]); w1.z = pk2(o1[4], o1[5]); w1.w = pk2(o1[6], o1[7]);
                *(LAS u32x4*)(lds + off + (2 * lane) * 144 + wave * 16) = w0;
                *(LAS u32x4*)(lds + off + (2 * lane + 1) * 144 + wave * 16) = w1;
            }
        }
        if (n + 1 < 32) {
#pragma unroll
            for (int w = 0; w < 3; ++w) {
                const bf16_t* rbase = proj + (size_t)(t0 + 64 + wave * 8 - 3) * PJ1 + w * 1024 + h * 128;
#pragma unroll
                for (int i = 0; i < 11; ++i) rawq[w][i] = *(const unsigned*)(rbase + i * PJ1 + 2 * lane);
            }
            gbl = gb[(size_t)(t0 + 64 + lane) * 16 + h]; gai = gb[(size_t)(t0 + 64 + lane) * 16 + 8 + h];
        }
        lds_barrier();
        {
            const int trr = wave & 3;
            const int aoffb = (wave < 4) ? K_OFF : Q_OFF;
            bf16x8 af[4];
#pragma unroll
            for (int ks = 0; ks < 4; ++ks) af[ks] = ldsfrag(lds + aoffb + (trr * 16 + fr) * 272 + (ks * 32 + fq * 8) * 2);
            const f32x4 gi4 = *(const LAS f32x4*)(gcs + trr * 16 + fq * 4), bi4 = *(const LAS f32x4*)(betas + trr * 16 + fq * 4);
            float gj4[4];
#pragma unroll
            for (int tc = 0; tc < 4; ++tc) gj4[tc] = gcs[tc * 16 + fr];
            __builtin_amdgcn_sched_barrier(0);
#pragma unroll
            for (int tc = 0; tc < 4; ++tc) {
                f32x4 a = (f32x4){0.f, 0.f, 0.f, 0.f};
                bf16x8 bfr[4];
#pragma unroll
                for (int ks = 0; ks < 4; ++ks) bfr[ks] = ldsfrag(lds + K_OFF + (tc * 16 + fr) * 272 + (ks * 32 + fq * 8) * 2);
#pragma unroll
                for (int ks = 0; ks < 4; ++ks) a = MFMA16(af[ks], bfr[ks], a);
                const int j = tc * 16 + fr;
                const float gj = gj4[tc];
#pragma unroll
                for (int jj = 0; jj < 4; ++jj) {
                    const int i = trr * 16 + fq * 4 + jj;
                    const float gi = gi4[jj];
                    if (wave < 4) { Lm[i * 64 + j] = (j < i) ? bi4[jj] * a[jj] * __expf(gi - gj) : 0.f; }
                    else { *(LAS bf16_t*)(lds + ATT_OFF + i * 144 + j * 2) = (bf16_t)f2bf((j <= i) ? a[jj] * __expf(gi - gj) : 0.f); }
                }
            }
        }
        lds_barrier();
        if (wave == 0) {
            const int blk = lane >> 5, cl = lane & 31;
            LAS unsigned char* Lbytes = lds + L_OFF;
            LAS unsigned char* L21b = (LAS unsigned char*)part;
            {
                const int r = lane >> 1, hh = lane & 1;
                f32x4 x[4];
#pragma unroll
                for (int q = 0; q < 4; ++q) x[q] = *(const LAS f32x4*)(Lm + (32 + r) * 64 + hh * 16 + q * 4);
                u32x4 w0, w1;
                w0.x = pk2(x[0][0], x[0][1]); w0.y = pk2(x[0][2], x[0][3]); w0.z = pk2(x[1][0], x[1][1]); w0.w = pk2(x[1][2], x[1][3]);
                w1.x = pk2(x[2][0], x[2][1]); w1.y = pk2(x[2][2], x[2][3]); w1.z = pk2(x[3][0], x[3][1]); w1.w = pk2(x[3][2], x[3][3]);
                *(LAS u32x4*)(L21b + r * 64 + hh * 32) = w0; *(LAS u32x4*)(L21b + r * 64 + hh * 32 + 16) = w1;
            }
            const LAS float* Lblk = Lm + blk * (32 * 64 + 32);
            float Tc[32];
#pragma unroll
            for (int i = 0; i < 32; ++i) {
                float s0 = (cl == i) ? 1.0f : 0.0f, s1 = 0.f, s2 = 0.f, s3 = 0.f;
                f32x4 lr[8];
#pragma unroll
                for (int j4 = 0; j4 < (i + 3) / 4; ++j4) lr[j4] = *(const LAS f32x4*)(Lblk + i * 64 + j4 * 4);
                __builtin_amdgcn_sched_barrier(0);
#pragma unroll
                for (int j4 = 0; j4 < (i + 3) / 4; ++j4) {
                    const f32x4 l4 = lr[j4];
                    if (j4 * 4 + 0 < i) s0 -= l4[0] * Tc[j4 * 4 + 0];
                    if (j4 * 4 + 1 < i) s1 -= l4[1] * Tc[j4 * 4 + 1];
                    if (j4 * 4 + 2 < i) s2 -= l4[2] * Tc[j4 * 4 + 2];
                    if (j4 * 4 + 3 < i) s3 -= l4[3] * Tc[j4 * 4 + 3];
                }
                Tc[i] = (s0 + s1) + (s2 + s3);
            }
            const float sc1 = beta * egc, sc2 = beta;
#pragma unroll
            for (int i = 0; i < 32; ++i) {
                const int row = blk * 32 + i;
                *(LAS bf16_t*)(lds + TP_OFF + row * 144 + lane * 2) = (bf16_t)f2bf(Tc[i] * sc1);
                *(LAS bf16_t*)(lds + TPP_OFF + row * 144 + lane * 2) = (bf16_t)f2bf(Tc[i] * sc2);
            }
            if (blk == 1) {
#pragma unroll
                for (int i = 0; i < 32; ++i) { *(LAS bf16_t*)(lds + TP_OFF + i * 144 + lane * 2) = (bf16_t)0; *(LAS bf16_t*)(lds + TPP_OFF + i * 144 + lane * 2) = (bf16_t)0; }
            }
            LAS unsigned char* T11t = Lbytes, *T22n = Lbytes + 2048, *Xt = Lbytes + 4096;
            if (blk == 0) {
#pragma unroll
                for (int q = 0; q < 4; ++q) {
                    u32x4 w; w.x = pk2(Tc[q * 8 + 0], Tc[q * 8 + 1]); w.y = pk2(Tc[q * 8 + 2], Tc[q * 8 + 3]); w.z = pk2(Tc[q * 8 + 4], Tc[q * 8 + 5]); w.w = pk2(Tc[q * 8 + 6], Tc[q * 8 + 7]);
                    *(LAS u32x4*)(T11t + cl * 64 + q * 16) = w;
                }
            } else {
#pragma unroll
                for (int i = 0; i < 32; ++i) *(LAS bf16_t*)(T22n + i * 64 + cl * 2) = (bf16_t)f2bf(Tc[i]);
            }
            f32x4 xacc[2][2];
#pragma unroll
            for (int ti = 0; ti < 2; ++ti)
#pragma unroll
                for (int tj = 0; tj < 2; ++tj)
                    xacc[ti][tj] = MFMA16(ldsfrag(L21b + (ti * 16 + fr) * 64 + fq * 16), ldsfrag(T11t + (tj * 16 + fr) * 64 + fq * 16), ((f32x4){0.f, 0.f, 0.f, 0.f}));
#pragma unroll
            for (int ti = 0; ti < 2; ++ti)
#pragma unroll
                for (int tj = 0; tj < 2; ++tj) {
                    u32x2 w; w.x = pk2(xacc[ti][tj][0], xacc[ti][tj][1]); w.y = pk2(xacc[ti][tj][2], xacc[ti][tj][3]);
                    *(LAS u32x2*)(Xt + (tj * 16 + fr) * 64 + (ti * 16 + fq * 4) * 2) = w;
                }
#pragma unroll
            for (int tj = 0; tj < 2; ++tj) {
                const int col = tj * 16 + fr;
                const float c1 = -betas[col] * egcs[col], c2 = -betas[col];
#pragma unroll
                for (int ti = 0; ti < 2; ++ti) {
                    const f32x4 t = MFMA16(ldsfrag(T22n + (ti * 16 + fr) * 64 + fq * 16), ldsfrag(Xt + (tj * 16 + fr) * 64 + fq * 16), ((f32x4){0.f, 0.f, 0.f, 0.f}));
#pragma unroll
                    for (int jj = 0; jj < 4; ++jj) {
                        const int row = 32 + ti * 16 + fq * 4 + jj;
                        *(LAS bf16_t*)(lds + TP_OFF + row * 144 + col * 2) = (bf16_t)f2bf(t[jj] * c1);
                        *(LAS bf16_t*)(lds + TPP_OFF + row * 144 + col * 2) = (bf16_t)f2bf(t[jj] * c2);
                    }
                }
            }
        }
        lds_barrier();
        f32x4 uacc[4];
        {
            bf16x8 vb[2], kb[2];
#pragma unroll
            for (int ks = 0; ks < 2; ++ks) { vb[ks] = ldsfrag(lds + VT_OFF + (16 * wave + fr) * 144 + (ks * 32 + fq * 8) * 2); kb[ks] = ldsfrag(lds + KT_OFF + (16 * wave + fr) * 144 + (ks * 32 + fq * 8) * 2); }
#pragma unroll
            for (int tt = 0; tt < 4; ++tt) {
                f32x4 au = (f32x4){0.f, 0.f, 0.f, 0.f}, aw = (f32x4){0.f, 0.f, 0.f, 0.f};
#pragma unroll
                for (int ks = 0; ks < 2; ++ks) {
                    au = MFMA16(ldsfrag(lds + TPP_OFF + (tt * 16 + fr) * 144 + (ks * 32 + fq * 8) * 2), vb[ks], au);
                    aw = MFMA16(ldsfrag(lds + TP_OFF + (tt * 16 + fr) * 144 + (ks * 32 + fq * 8) * 2), kb[ks], aw);
                }
                uacc[tt] = au;
#pragma unroll
                for (int jj = 0; jj < 4; ++jj) *(LAS bf16_t*)(lds + K_OFF + (tt * 16 + fq * 4 + jj) * 272 + (16 * wave + fr) * 2) = (bf16_t)f2bf(aw[jj]);
            }
        }
        lds_barrier();
        {
            bf16x8 sb[4];
#pragma unroll
            for (int ks = 0; ks < 4; ++ks) sb[ks] = ldsfrag(lds + ST_OFF + (16 * wave + fr) * 272 + (ks * 32 + fq * 8) * 2);
#pragma unroll
            for (int tt = 0; tt < 4; ++tt) {
                f32x4 a = (f32x4){0.f, 0.f, 0.f, 0.f};
                bf16x8 wf[4];
#pragma unroll
                for (int ks = 0; ks < 4; ++ks) wf[ks] = ldsfrag(lds + K_OFF + (tt * 16 + fr) * 272 + (ks * 32 + fq * 8) * 2);
                const f32x4 d4 = *(const LAS f32x4*)(djs + tt * 16 + fq * 4);
#pragma unroll
                for (int ks = 0; ks < 4; ++ks) a = MFMA16(wf[ks], sb[ks], a);
                const f32x4 vn = uacc[tt] - a;
                u32x2 p0, p1;
                p0.x = pk2(vn[0], vn[1]); p0.y = pk2(vn[2], vn[3]);
                p1.x = pk2(vn[0] * d4[0], vn[1] * d4[1]); p1.y = pk2(vn[2] * d4[2], vn[3] * d4[3]);
                *(LAS u32x2*)(lds + VN_OFF + (16 * wave + fr) * 144 + (tt * 16 + fq * 4) * 2) = p0;
                *(LAS u32x2*)(lds + VNS_OFF + (16 * wave + fr) * 144 + (tt * 16 + fq * 4) * 2) = p1;
            }
        }
        lds_barrier();
        f32x4 oacc[4];
        unsigned zr[4][4];
        const bf16_t* zbase = proj + (size_t)t0 * PJ1 + 3072 + h * 128 + 16 * wave;
        const int zoffl = fq * 4 * PJ1 + fr;
        {
#pragma unroll
            for (int tt = 0; tt < 4; ++tt)
#pragma unroll
                for (int jj = 0; jj < 4; ++jj) zr[tt][jj] = zbase[(tt * 16 + jj) * PJ1 + zoffl];
            bf16x8 sb[4], vnb[2];
#pragma unroll
            for (int ks = 0; ks < 4; ++ks) sb[ks] = ldsfrag(lds + ST_OFF + (16 * wave + fr) * 272 + (ks * 32 + fq * 8) * 2);
#pragma unroll
            for (int ks = 0; ks < 2; ++ks) vnb[ks] = ldsfrag(lds + VN_OFF + (16 * wave + fr) * 144 + (ks * 32 + fq * 8) * 2);
#pragma unroll
            for (int tt = 0; tt < 4; ++tt) {
                f32x4 a = (f32x4){0.f, 0.f, 0.f, 0.f};
                bf16x8 qf[4], atf[2];
#pragma unroll
                for (int ks = 0; ks < 4; ++ks) qf[ks] = ldsfrag(lds + Q_OFF + (tt * 16 + fr) * 272 + (ks * 32 + fq * 8) * 2);
#pragma unroll
                for (int ks = 0; ks < 2; ++ks) atf[ks] = ldsfrag(lds + ATT_OFF + (tt * 16 + fr) * 144 + (ks * 32 + fq * 8) * 2);
                const f32x4 e4 = *(const LAS f32x4*)(egcs + tt * 16 + fq * 4);
#pragma unroll
                for (int ks = 0; ks < 4; ++ks) a = MFMA16(qf[ks], sb[ks], a);
                a = a * e4;
#pragma unroll
                for (int ks = 0; ks < 2; ++ks) a = MFMA16(atf[ks], vnb[ks], a);
                oacc[tt] = a;
#pragma unroll
                for (int jj = 0; jj < 4; ++jj) {
                    const float s = row16_sum(a[jj] * a[jj]);
                    if (fr == 0) part[wave * 64 + tt * 16 + fq * 4 + jj] = s;
                }
            }
            const float glast = __expf(gc_last);
            bf16x8 vsb[2];
#pragma unroll
            for (int ks = 0; ks < 2; ++ks) vsb[ks] = ldsfrag(lds + VNS_OFF + (16 * wave + fr) * 144 + (ks * 32 + fq * 8) * 2);
#pragma unroll
            for (int dt = 0; dt < 8; ++dt) {
                f32x4 a = Sacc[dt] * glast;
                bf16x8 kf[2];
#pragma unroll
                for (int ks = 0; ks < 2; ++ks) kf[ks] = ldsfrag(lds + KT_OFF + (dt * 16 + fr) * 144 + (ks * 32 + fq * 8) * 2);
#pragma unroll
                for (int ks = 0; ks < 2; ++ks) a = MFMA16(kf[ks], vsb[ks], a);
                Sacc[dt] = a;
            }
        }
        lds_barrier();
        {
            bf16_t* obase = proj + (size_t)t0 * PJ1 + 3072 + h * 128 + 16 * wave;
            const int ooffl = fq * 4 * PJ1 + fr;
#pragma unroll
            for (int dt = 0; dt < 8; ++dt) {
                u32x2 p; p.x = pk2(Sacc[dt][0], Sacc[dt][1]); p.y = pk2(Sacc[dt][2], Sacc[dt][3]);
                *(LAS u32x2*)(lds + ST_OFF + (16 * wave + fr) * 272 + (dt * 16 + fq * 4) * 2) = p;
            }
#pragma unroll
            for (int tt = 0; tt < 4; ++tt) {
                f32x4 pw[8];
#pragma unroll
                for (int w = 0; w < 8; ++w) pw[w] = *(const LAS f32x4*)(part + w * 64 + tt * 16 + fq * 4);
                __builtin_amdgcn_sched_barrier(0);
                const f32x4 ss = ((pw[0] + pw[1]) + (pw[2] + pw[3])) + ((pw[4] + pw[5]) + (pw[6] + pw[7]));
#pragma unroll
                for (int jj = 0; jj < 4; ++jj) {
                    const float rstd = rsqrtf(ss[jj] * (1.0f / 128.0f) + 1e-6f);
                    const float z = bf2f(zr[tt][jj]);
                    const float o = oacc[tt][jj] * rstd * ng * siluf_(z);
                    obase[(tt * 16 + jj) * PJ1 + ooffl] = (bf16_t)f2bf(o);
                }
            }
        }
    }
    __syncthreads();
}

__global__ void __launch_bounds__(NTHREADS, 2) mega(Params P) {
    extern __shared__ __attribute__((aligned(16))) unsigned char lds_raw[];
    LAS unsigned char* lds = (LAS unsigned char*)lds_raw;
    cg::grid_group grid = cg::this_grid();
    unsigned char* ws = P.ws;
    bf16_t* const XB0 = (bf16_t*)(ws + WS_XB0);
    bf16_t* const XBN = (bf16_t*)(ws + 768 * MiB);
    bf16_t* PB = (bf16_t*)(ws + WS_PB);
    bf16_t* BIGb = (bf16_t*)(ws + WS_BIG);
    bf16_t* const YC0 = (bf16_t*)(ws + WS_BIG) + (size_t)T_ * PJ0;
    bf16_t* const VB = (bf16_t*)(ws + 736 * MiB);
    float* GB = (float*)(ws + WS_GB);
    float* XF = P.out;
    const int G = gridDim.x, bid = blockIdx.x;

    for (int ph = P.ph_lo; ph < P.ph_hi; ++ph) {
        if (ph > P.ph_lo) grid.sync();
        if (ph == 0) { phase_convert(P, lds); continue; }
        const int l = (ph >= 13) ? 1 : 0, s = (ph >= 13) ? (ph - 13) : (ph - 1);
        bf16_t* xcur = XB0;
        bf16_t* xoth = XB0;
        const float* lng = P.in[8] + (size_t)l * 3 * D_;
        const float* lnb = P.in[9] + (size_t)l * 3 * D_;
        if (s == 0 || s == 7) {
            const bf16_t* up = (const bf16_t*)(ws + W_FFN + (size_t)(l * 2 + (s == 7)) * (SZ_UP + SZ_DN));
            pg8::Gemm g{(l == 1 && s == 0) ? XBN : xcur, up, T_, 5632, D_, D_}; pg8::StaticOrder S; S.init(T_, 5632, G, bid);
            EpiSwiglu E{BIGb};
            pg8::gemm_phase<EpiSwiglu>(lds, g, S, E);
        } else if (s == 1 || s == 8 || s == 5) {
            const bf16_t* A; const bf16_t* Bt; int K, lda; float scale;
            if (s == 5) { A = (l == 0) ? YC0 : (BIGb + 3072); lda = (l == 0) ? D_ : PJ1; Bt = (const bf16_t*)(ws + (l == 0 ? W_AB_OUT : W_C_OUT)); K = D_; scale = 1.0f; }
            else { A = BIGb; lda = FF_; Bt = (const bf16_t*)(ws + W_FFN + (size_t)(l * 2 + (s == 8)) * (SZ_UP + SZ_DN) + SZ_UP); K = FF_; scale = 0.5f; }
            const float* res = (l == 0 && s == 1) ? P.in[0] : XF;
            const bf16_t* resb = (s == 8 || s == 5) ? xcur : ((s == 1 && l == 1) ? XBN : (const bf16_t*)nullptr);
            bf16_t* vout = (s == 5 || (s == 1 && l == 1)) ? (bf16_t*)XF : VB;
            pg8::Gemm g{A, Bt, T_, D_, K, lda}; pg8::StaticOrder S; S.init(T_, D_, G, bid);
            EpiResid<true> E{res, vout, resb, scale == 0.5f ? 1 : 0};
            pg8::gemm_phase<EpiResid<true>>(lds, g, S, E);
        } else if (s == 2 || s == 6 || s == 9) {
            const int k = (s == 2) ? 0 : (s == 6 ? 1 : 2);
            phase_ln((k == 1 || (k == 0 && l == 1)) ? (const bf16_t*)XF : VB, XF, xcur, lng + k * D_, lnb + k * D_, false);
            if (s == 2 && l == 1) conv_plain(P.in[1] + (size_t)T_ * 256, PB, (size_t)T_ * 256);
        } else if (s == 3) {
            const bf16_t* Bt = (const bf16_t*)(ws + (l == 0 ? W_AB_IN : W_C_IN));
            const int N = (l == 0) ? 1792 : 4352;
            pg8::Gemm g{xcur, Bt, T_, N, D_, D_}; pg8::StaticOrder S; S.init(T_, N, G, bid);
            EpiProj E{BIGb, l == 0 ? PJ0 : PJ1, l == 0 ? 7 : 16, GB};
            pg8::gemm_phase<EpiProj>(lds, g, S, E);
        } else if (s == 4) {
            if (l == 0) phase_mixer0(P, lds, BIGb, YC0);
            else for (int u = bid; u < 256; u += G) gdn_unit(P, BIGb, GB, u >> 3, u & 7, lds);
        } else if (s == 10) {
            const bf16_t* Bt = (const bf16_t*)(ws + W_PLE + (size_t)l * SZ_PLE + 2097152);
            pg8::Gemm g{PB, Bt, T_, D_, 256, 256}; pg8::StaticOrder S; S.init(T_, D_, G, bid);
            EpiResid<false> E{nullptr, BIGb, nullptr, 0};
            pg8::gemm_phase<EpiResid<false>>(lds, g, S, E);
        } else {
            const bf16_t* Bt = (const bf16_t*)(ws + W_PLE + (size_t)l * SZ_PLE);
            pg8::Gemm g{xcur, Bt, T_, D_, D_, D_}; pg8::StaticOrder S; S.init(T_, D_, G, bid);
            EpiPle E{xcur, BIGb, P.in[11] + (size_t)l * D_, l == 1 ? XF : (float*)nullptr, l == 0 ? XBN : (bf16_t*)nullptr};
            pg8::gemm_phase<EpiPle>(lds, g, S, E);
        }
    }
}

constexpr int N_PHASES = 25;
extern "C" void kernel_launch(void* const* d_in, const int* in_sizes, int n_in, void* d_out, int out_size, void* d_ws, size_t ws_size, hipStream_t stream) {
    static int ready = 0;
    if (!ready) {
        if (n_in != 29 || ws_size < WS_NEED) { fprintf(stderr, "kernel_launch: unexpected problem (n_in %d, ws %zu, need %zu)\n", n_in, ws_size, (size_t)WS_NEED); }
        if (hipFuncSetAttribute((const void*)mega, hipFuncAttributeMaxDynamicSharedMemorySize, LDS_BYTES) != hipSuccess) fprintf(stderr, "kernel_launch: hipFuncSetAttribute failed\n");
        ready = 1;
    }
    Params p{};
    for (int i = 0; i < 29; ++i) p.in[i] = (const float*)d_in[i];
    p.out = (float*)d_out; p.ws = (unsigned char*)d_ws;
#if MULTI_LAUNCH
    for (int ph = 0; ph < N_PHASES; ++ph) {
        p.ph_lo = ph; p.ph_hi = ph + 1;
        hipLaunchKernelGGL(mega, dim3(256), dim3(NTHREADS), LDS_BYTES, stream, p);
    }
#else
    p.ph_lo = 0; p.ph_hi = N_PHASES;
    void* args[] = {&p};
    hipError_t e = hipLaunchCooperativeKernel((const void*)mega, dim3(256), dim3(NTHREADS), args, LDS_BYTES, stream);
    if (e != hipSuccess) fprintf(stderr, "cooperative launch failed: %s\n", hipGetErrorString(e));
#endif
}
```
